# Optimizing an MI355X kernel written in HIP

```python
import math
import jax
import jax.numpy as jnp
from jax import lax
import numpy as np


D_MODEL = 1024
BATCH = 4
SEQ = 8192
DEPTH = 2

D_INNER = 2 * D_MODEL
GROUP_W = D_INNER // 4
SHORT_CONV = 3
RMS_EPS = 1e-6

HY_W = GROUP_W
HY_ORDER = 2
HY_POS_BANDS = 8
HY_POS_DIM = 1 + 2 * HY_POS_BANDS
HY_FILT_HID = 64
HY_FILT_OUT = HY_ORDER * 2 * HY_W

MB_W = GROUP_W
MB_HEADDIM = 64
MB_H = MB_W // MB_HEADDIM
MB_GROUPS = 2
MB_STATE = 128
MB_XBC = MB_W + 2 * MB_GROUPS * MB_STATE
MB_CHUNK = 128

ML_W = GROUP_W
ML_H = 4
ML_DH = ML_W // ML_H
ML_CHUNK = 128

NA_W = GROUP_W
NA_DH = 64
NA_H = NA_W // NA_DH
NA_KR_MAX = 8
NA_KC = 16
GRID_W = 64

IN_SPLITS = (3 * HY_W, HY_W, MB_XBC, MB_W, 2 * MB_H, 2 * ML_W, ML_W, ML_W, ML_W, 4 * ML_H, 3 * NA_W, NA_W)
N_IN = sum(IN_SPLITS)

kernel_name = "hybrid_parallel_heads_encoder"


def _split_cols(h, widths):
    out, start = [], 0
    for w in widths:
        out.append(h[..., start:start + w])
        start += w
    return out


def _rmsnorm(x, w):
    xf = x.astype(jnp.float32)
    y = xf * lax.rsqrt(jnp.mean(xf * xf, axis=-1, keepdims=True) + RMS_EPS)
    return (y * w.astype(jnp.float32)).astype(x.dtype)


def _short_conv(u, w, b):
    pad = w.shape[0] // 2
    y = lax.conv_general_dilated(u, w[:, None, :], window_strides=(1,), padding=[(pad, pad)],
                                 dimension_numbers=('NWC', 'WIO', 'NWC'), feature_group_count=u.shape[-1])
    return y + b


def _hyena_positions(L):
    t = jnp.arange(L, dtype=jnp.float32)
    t_norm = t / L
    bands = jnp.arange(1, HY_POS_BANDS + 1, dtype=jnp.float32)
    ang = (2.0 * math.pi / L) * t[:, None] * bands[None, :]
    pos = jnp.concatenate([t_norm[:, None], jnp.cos(ang), jnp.sin(ang)], axis=-1)
    return pos, t_norm


def _hyena_filters(pos, t_norm, w1, b1, w2, b2, w3, freq, decay):
    hid = jnp.sin(freq * (pos @ w1 + b1))
    hid = jnp.sin(freq * (hid @ w2 + b2))
    filt = (hid @ w3) * jnp.exp(-t_norm[:, None] * decay)
    return filt.reshape(-1, HY_ORDER, 2, HY_W)


def _bidir_fftconv(u, h_fwd, h_bwd, skip):
    L, C = h_fwd.shape
    n = 2 * L
    g = jnp.concatenate([h_fwd, jnp.zeros((1, C), h_fwd.dtype), h_bwd[:0:-1]], axis=0).astype(jnp.float32)
    uf = u.astype(jnp.float32)
    y = jnp.fft.irfft(jnp.fft.rfft(uf, n=n, axis=1) * jnp.fft.rfft(g, n=n, axis=0)[None], n=n, axis=1)[:, :L]
    return (y + uf * skip.astype(jnp.float32)).astype(u.dtype)


def _hyena_branch(u3, gate, conv_w, conv_b, filt, skip):
    u3 = _short_conv(u3, conv_w, conv_b)
    v, x1, x2 = _split_cols(u3, (HY_W, HY_W, HY_W))
    z = x1 * _bidir_fftconv(v, filt[:, 0, 0], filt[:, 0, 1], skip[0])
    y = x2 * _bidir_fftconv(z, filt[:, 1, 0], filt[:, 1, 1], skip[1])
    return y * jax.nn.silu(gate)


def _segsum_exp(a):
    T = a.shape[-1]
    cs = jnp.cumsum(a, axis=-1)
    mask = jnp.tril(jnp.ones((T, T), dtype=bool))
    return jnp.exp(jnp.where(mask, cs[..., :, None] - cs[..., None, :], -jnp.inf))


def _ssd_scan(x, dt, A, Bm, Cm):
    bsz, L, H, P = x.shape
    G, N = Bm.shape[2], Bm.shape[3]
    J = H // G
    Q = MB_CHUNK
    nc = L // Q
    xc = (x * dt[..., None]).reshape(bsz, nc, Q, G, J, P)
    a = (dt * A).reshape(bsz, nc, Q, G, J).transpose(0, 3, 4, 1, 2)
    Bc = Bm.reshape(bsz, nc, Q, G, N)
    Cc = Cm.reshape(bsz, nc, Q, G, N)
    a_cs = jnp.cumsum(a, axis=-1)
    CB = jnp.einsum('bclgn,bcsgn->bcgls', Cc, Bc)
    y_diag = jnp.einsum('bcgls,bgjcls,bcsgjp->bclgjp', CB, _segsum_exp(a), xc)
    decay_states = jnp.exp(a_cs[..., -1:] - a_cs)
    states = jnp.einsum('bcsgn,bgjcs,bcsgjp->bcgjpn', Bc, decay_states, xc)
    states = jnp.concatenate([jnp.zeros_like(states[:, :1]), states], axis=1)
    decay_chunk = _segsum_exp(jnp.pad(a_cs[..., -1], ((0, 0), (0, 0), (0, 0), (1, 0))))
    prev_states = jnp.einsum('bgjzc,bcgjpn->bzgjpn', decay_chunk, states)[:, :-1]
    y_off = jnp.einsum('bclgn,bcgjpn,bgjcl->bclgjp', Cc, prev_states, jnp.exp(a_cs))
    return (y_diag + y_off).reshape(bsz, L, H, P)


def _mamba2_branch(xbc, z, dt_raw, conv_w, conv_b, dt_bias, a_log, d_skip, norm_w):
    bsz, L, _ = xbc.shape
    xbc = jax.nn.silu(_short_conv(xbc, conv_w, conv_b))
    xs, bm, cm = _split_cols(xbc, (MB_W, MB_GROUPS * MB_STATE, MB_GROUPS * MB_STATE))
    xs = xs.reshape(bsz, L, MB_H, MB_HEADDIM).astype(jnp.float32)
    bm = bm.reshape(bsz, L, MB_GROUPS, MB_STATE).astype(jnp.float32)
    cm = cm.reshape(bsz, L, MB_GROUPS, MB_STATE).astype(jnp.float32)
    dt = jax.nn.softplus(dt_raw.reshape(bsz, L, 2, MB_H).astype(jnp.float32) + dt_bias.astype(jnp.float32))
    A = -jnp.exp(a_log.astype(jnp.float32))
    y_f = _ssd_scan(xs, dt[:, :, 0], A[0], bm, cm)
    y_b = jnp.flip(_ssd_scan(jnp.flip(xs, 1), jnp.flip(dt[:, :, 1], 1), A[1], jnp.flip(bm, 1), jnp.flip(cm, 1)), 1)
    y = (y_f + y_b + xs * d_skip.astype(jnp.float32)[:, None]).reshape(bsz, L, MB_W)
    y = y.astype(z.dtype) * jax.nn.silu(z)
    y = _rmsnorm(y.reshape(bsz, L, MB_GROUPS, MB_W // MB_GROUPS), norm_w.reshape(MB_GROUPS, MB_W // MB_GROUPS))
    return y.reshape(bsz, L, MB_W)


def _mlstm_scan(q, k, v, ig, lf):
    bsz, H, L, Dh = q.shape
    Q = ML_CHUNK
    nc = L // Q

    def to_chunks(a):
        return jnp.moveaxis(a.reshape(bsz, H, nc, Q, *a.shape[3:]), 2, 0)

    causal = jnp.tril(jnp.ones((Q, Q), dtype=bool))

    def step(carry, inp):
        Cm, n, m = carry
        qq, kk, vv, ii, ff = inp
        b = jnp.cumsum(ff, axis=-1)
        dmat = jnp.where(causal, b[..., :, None] - b[..., None, :] + ii[..., None, :], -jnp.inf)
        m_inter = b + m[..., None]
        m_t = jnp.maximum(m_inter, jnp.max(dmat, axis=-1))
        w_inter = jnp.exp(m_inter - m_t)
        s = jnp.einsum('bhtd,bhsd->bhts', qq, kk) * jnp.exp(dmat - m_t[..., None])
        num = w_inter[..., None] * jnp.einsum('bhtd,bhde->bhte', qq, Cm) + jnp.einsum('bhts,bhse->bhte', s, vv)
        den = w_inter * jnp.einsum('bhtd,bhd->bht', qq, n) + jnp.sum(s, axis=-1)
        h = num / jnp.maximum(jnp.abs(den), jnp.exp(-m_t))[..., None]
        b_last = b[..., -1]
        g = b_last[..., None] - b + ii
        m_new = jnp.maximum(b_last + m, jnp.max(g, axis=-1))
        wk = jnp.exp(g - m_new[..., None])
        decay = jnp.exp(b_last + m - m_new)
        C_new = decay[..., None, None] * Cm + jnp.einsum('bhs,bhsd,bhse->bhde', wk, kk, vv)
        n_new = decay[..., None] * n + jnp.einsum('bhs,bhsd->bhd', wk, kk)
        return (C_new, n_new, m_new), h

    init = (jnp.zeros((bsz, H, Dh, Dh), jnp.float32), jnp.zeros((bsz, H, Dh), jnp.float32),
            jnp.zeros((bsz, H), jnp.float32))
    _, hs = lax.scan(step, init, (to_chunks(q), to_chunks(k), to_chunks(v), to_chunks(ig), to_chunks(lf)))
    return jnp.moveaxis(hs, 0, 2).reshape(bsz, H, L, Dh)


def _mlstm_branch(qk, v, o, z, gates, conv_w, conv_b, gate_b, norm_w):
    bsz, L, _ = v.shape
    qk = jax.nn.silu(_short_conv(qk, conv_w, conv_b))

    def heads(t):
        return t.reshape(bsz, L, ML_H, ML_DH).transpose(0, 2, 1, 3).astype(jnp.float32)

    q = heads(qk[..., :ML_W])
    k = heads(qk[..., ML_W:]) * (ML_DH ** -0.5)
    vv = heads(v)
    g = gates.reshape(bsz, L, 2, 2, ML_H).astype(jnp.float32) + gate_b.astype(jnp.float32)
    g = g.transpose(2, 3, 0, 4, 1)
    ig = g[:, 0]
    lf = jax.nn.log_sigmoid(g[:, 1])
    h_f = _mlstm_scan(q, k, vv, ig[0], lf[0])
    h_b = jnp.flip(_mlstm_scan(jnp.flip(q, 2), jnp.flip(k, 2), jnp.flip(vv, 2),
                               jnp.flip(ig[1], 2), jnp.flip(lf[1], 2)), 2)
    h = (h_f + h_b).transpose(0, 2, 1, 3).reshape(bsz, L, ML_W)
    h = jax.nn.sigmoid(o.astype(jnp.float32)) * h
    h = _rmsnorm(h.reshape(bsz, L, ML_H, ML_DH), norm_w.reshape(ML_H, ML_DH)).reshape(bsz, L, ML_W)
    return h.astype(z.dtype) * jax.nn.silu(z)


def _neighbourhood_attention(q, k, v, rpb):
    bsz, seq, nh, dh = q.shape
    rows = seq // GRID_W
    kr = min(NA_KR_MAX, rows)
    kc = NA_KC
    qg = q.reshape(bsz, rows, GRID_W, nh, dh)
    kg = k.reshape(bsz, rows, GRID_W, nh, dh)
    vg = v.reshape(bsz, rows, GRID_W, nh, dh)
    row_start = jnp.clip(jnp.arange(rows) - kr // 2, 0, rows - kr)
    cols = jnp.arange(GRID_W)
    col_idx = jnp.clip(cols - kc // 2, 0, GRID_W - kc)[:, None] + jnp.arange(kc)[None, :]
    col_off = col_idx - cols[:, None] + (kc - 1)
    rpb_cols = rpb[:, :, col_off]

    def one_row(r):
        rs = row_start[r]
        q_row = lax.dynamic_index_in_dim(qg, r, axis=1, keepdims=False)
        k_win = lax.dynamic_slice_in_dim(kg, rs, kr, axis=1)[:, :, col_idx]
        v_win = lax.dynamic_slice_in_dim(vg, rs, kr, axis=1)[:, :, col_idx]
        row_off = rs + jnp.arange(kr) - r + (NA_KR_MAX - 1)
        bias = rpb_cols[:, row_off].transpose(0, 2, 1, 3)
        s = jnp.einsum('bwhd,biwjhd->bhwij', q_row, k_win).astype(jnp.float32) + bias.astype(jnp.float32)
        p = jax.nn.softmax(s.reshape(bsz, nh, GRID_W, kr * kc), axis=-1).reshape(s.shape)
        return jnp.einsum('bhwij,biwjhd->bwhd', p.astype(v.dtype), v_win)

    out = lax.map(one_row, jnp.arange(rows))
    return out.transpose(1, 0, 2, 3, 4).reshape(bsz, seq, nh, dh)


def _na_branch(qkv, gate, qn_w, kn_w, rpb):
    bsz, L, _ = qkv.shape
    q, k, v = [t.reshape(bsz, L, NA_H, NA_DH) for t in _split_cols(qkv, (NA_W, NA_W, NA_W))]
    q = _rmsnorm(q, qn_w) * (NA_DH ** -0.5)
    k = _rmsnorm(k, kn_w)
    o = _neighbourhood_attention(q, k, v, rpb)
    return o.reshape(bsz, L, NA_W) * jax.nn.silu(gate)


def setup_inputs(seed: int = 0) -> dict:
    key = jax.random.key(seed)
    ks = iter(jax.random.split(key, 40))

    def nrm(shape, scale):
        return scale * jax.random.normal(next(ks), shape, jnp.float32)

    def near_one(shape, s=0.02):
        return 1.0 + s * jax.random.normal(next(ks), shape, jnp.float32)

    x = jax.random.normal(next(ks), (BATCH, SEQ, D_MODEL), jnp.float32)
    norm_w = near_one((DEPTH, D_MODEL))
    w_in = nrm((DEPTH, D_MODEL, N_IN), D_MODEL ** -0.5)
    w_out = nrm((DEPTH, D_INNER, D_MODEL), D_INNER ** -0.5)
    hy_conv_w = nrm((DEPTH, SHORT_CONV, 3 * HY_W), SHORT_CONV ** -0.5)
    hy_conv_b = nrm((DEPTH, 3 * HY_W), 0.01)
    hy_w1 = nrm((DEPTH, HY_POS_DIM, HY_FILT_HID), HY_POS_DIM ** -0.5)
    hy_b1 = nrm((DEPTH, HY_FILT_HID), 0.1)
    hy_w2 = nrm((DEPTH, HY_FILT_HID, HY_FILT_HID), HY_FILT_HID ** -0.5)
    hy_b2 = nrm((DEPTH, HY_FILT_HID), 0.1)
    hy_w3 = nrm((DEPTH, HY_FILT_HID, HY_FILT_OUT), 0.02 * HY_FILT_HID ** -0.5)
    hy_freq = near_one((DEPTH, HY_FILT_HID), 0.1)
    base_decay = jnp.abs(jnp.linspace(math.log(1e-2) / 1.5, math.log(1e-2) / 0.3, HY_W, dtype=jnp.float32))
    hy_decay = jnp.tile(base_decay, HY_ORDER * 2)[None, :] * near_one((DEPTH, HY_FILT_OUT), 0.05)
    hy_skip = near_one((DEPTH, HY_ORDER, HY_W), 0.1)
    mb_conv_w = nrm((DEPTH, SHORT_CONV, MB_XBC), SHORT_CONV ** -0.5)
    mb_conv_b = nrm((DEPTH, MB_XBC), 0.01)
    u = jax.random.uniform(next(ks), (DEPTH, 2, MB_H), jnp.float32)
    dt0 = jnp.exp(u * (math.log(0.1) - math.log(1e-3)) + math.log(1e-3))
    mb_dt_bias = dt0 + jnp.log(-jnp.expm1(-dt0))
    mb_a_log = jnp.log(jax.random.uniform(next(ks), (DEPTH, 2, MB_H), jnp.float32, 1.0, 16.0))
    mb_d = near_one((DEPTH, MB_H), 0.1)
    mb_norm_w = near_one((DEPTH, MB_W))
    ml_conv_w = nrm((DEPTH, SHORT_CONV, 2 * ML_W), SHORT_CONV ** -0.5)
    ml_conv_b = nrm((DEPTH, 2 * ML_W), 0.01)
    ig_b = nrm((DEPTH, 2, 1, ML_H), 0.1)
    fg_b = jnp.linspace(3.0, 6.0, ML_H, dtype=jnp.float32) + nrm((DEPTH, 2, 1, ML_H), 0.1)
    ml_gate_b = jnp.concatenate([ig_b, fg_b], axis=2)
    ml_norm_w = near_one((DEPTH, ML_W))
    na_qnorm_w = near_one((DEPTH, NA_DH))
    na_knorm_w = near_one((DEPTH, NA_DH))
    na_rpb = nrm((DEPTH, NA_H, 2 * NA_KR_MAX - 1, 2 * NA_KC - 1), 0.02)
    return {"x": x, "norm_w": norm_w, "w_in": w_in, "w_out": w_out,
            "hy_conv_w": hy_conv_w, "hy_conv_b": hy_conv_b, "hy_w1": hy_w1, "hy_b1": hy_b1,
            "hy_w2": hy_w2, "hy_b2": hy_b2, "hy_w3": hy_w3, "hy_freq": hy_freq, "hy_decay": hy_decay,
            "hy_skip": hy_skip, "mb_conv_w": mb_conv_w, "mb_conv_b": mb_conv_b, "mb_dt_bias": mb_dt_bias,
            "mb_a_log": mb_a_log, "mb_d": mb_d, "mb_norm_w": mb_norm_w, "ml_conv_w": ml_conv_w,
            "ml_conv_b": ml_conv_b, "ml_gate_b": ml_gate_b, "ml_norm_w": ml_norm_w,
            "na_qnorm_w": na_qnorm_w, "na_knorm_w": na_knorm_w, "na_rpb": na_rpb}


def reference(x, norm_w, w_in, w_out, hy_conv_w, hy_conv_b, hy_w1, hy_b1, hy_w2, hy_b2, hy_w3, hy_freq,
              hy_decay, hy_skip, mb_conv_w, mb_conv_b, mb_dt_bias, mb_a_log, mb_d, mb_norm_w, ml_conv_w,
              ml_conv_b, ml_gate_b, ml_norm_w, na_qnorm_w, na_knorm_w, na_rpb):
    L = x.shape[1]
    pos, t_norm = _hyena_positions(L)
    for l in range(DEPTH):
        h = _rmsnorm(x, norm_w[l])
        proj = h @ w_in[l]
        (hy_u, hy_g, mb_xbc, mb_z, mb_dt, ml_qk, ml_v, ml_o, ml_z, ml_gates, na_qkv, na_g) = _split_cols(proj, IN_SPLITS)
        filt = _hyena_filters(pos, t_norm, hy_w1[l], hy_b1[l], hy_w2[l], hy_b2[l], hy_w3[l], hy_freq[l], hy_decay[l])
        y_hy = _hyena_branch(hy_u, hy_g, hy_conv_w[l], hy_conv_b[l], filt, hy_skip[l])
        y_mb = _mamba2_branch(mb_xbc, mb_z, mb_dt, mb_conv_w[l], mb_conv_b[l], mb_dt_bias[l], mb_a_log[l],
                              mb_d[l], mb_norm_w[l])
        y_ml = _mlstm_branch(ml_qk, ml_v, ml_o, ml_z, ml_gates, ml_conv_w[l], ml_conv_b[l], ml_gate_b[l], ml_norm_w[l])
        y_na = _na_branch(na_qkv, na_g, na_qnorm_w[l], na_knorm_w[l], na_rpb[l])
        y = jnp.concatenate([y_hy, y_mb, y_ml, y_na], axis=-1)
        x = x + y @ w_out[l]
    return x
```

```cpp
#include <hip/hip_runtime.h>
#include <hip/hip_cooperative_groups.h>
#include <cstdio>
namespace cg = cooperative_groups;
__device__ __forceinline__ int ltid() { int t = threadIdx.x; asm volatile("" : "+v"(t)); return t; }

#define XB_TMO      128
#define XB_XCNT(j)  (256  + 64 * (j))
#define XB_XSUB(j)  (1280 + 64 * (j))
#define XB_XGEN(j)  (2304 + 64 * (j))
#define XB_TOP      3328
#define XB_TOPGEN   3392
#define XCD_BAR_WORDS 3456
#define XB_SPIN_CAP (1u << 18)
#define LAS __attribute__((address_space(3)))

__device__ __forceinline__ unsigned xb_ld(unsigned* p)              { return __hip_atomic_load(p, __ATOMIC_RELAXED, __HIP_MEMORY_SCOPE_AGENT); }
__device__ __forceinline__ unsigned xb_add(unsigned* p, unsigned v) { return __hip_atomic_fetch_add(p, v, __ATOMIC_RELAXED, __HIP_MEMORY_SCOPE_AGENT); }
__device__ __forceinline__ unsigned xb_xcc_id() { return (unsigned)__builtin_amdgcn_s_getreg((3 << 11) | 20) & 0xFu; }
#define XB_SPIN(cond, bar) do { unsigned _sp = 0; while (cond) { __builtin_amdgcn_s_sleep(1); \
    if ((++_sp & 255u) == 0u) { if (xb_ld(&(bar)[XB_TMO])) break; if (_sp > XB_SPIN_CAP) { atomicAdd(&(bar)[XB_TMO], 1u); break; } } } } while (0)

struct XcdBarrier {
    unsigned* bar; unsigned x;
    volatile LAS unsigned* st;
};

__device__ __forceinline__ XcdBarrier xcd_barrier_post(unsigned* bar, volatile LAS unsigned* st) {
    XcdBarrier b; b.bar = bar; b.x = xb_xcc_id(); b.st = st;
    if (threadIdx.x == 0) (void)xb_add(&bar[XB_XCNT(b.x)], 1u);
    return b;
}
__device__ __forceinline__ void xcd_barrier_complete(unsigned* bar, unsigned x, unsigned& nloc, unsigned& nx) {
    const unsigned G = gridDim.x * gridDim.y * gridDim.z;
    unsigned sum, cnt, mine, sp = 0u;
    for (;;) {
        sum = 0u; cnt = 0u; mine = 0u;
#pragma unroll
        for (unsigned j = 0; j < 16; ++j) { const unsigned c = xb_ld(&bar[XB_XCNT(j)]); sum += c; cnt += (c > 0u) ? 1u : 0u; mine = (j == x) ? c : mine; }
        if (sum == G) break;
        __builtin_amdgcn_s_sleep(1);
        if ((++sp & 255u) == 0u) { if (xb_ld(&bar[XB_TMO])) break; if (sp > XB_SPIN_CAP) { atomicAdd(&bar[XB_TMO], 1u); break; } }
    }
    nloc = mine > 0u ? mine : 1u; nx = cnt > 0u ? cnt : 1u;
}

__device__ __forceinline__ void xcd_barrier(const XcdBarrier& b) {
    asm volatile("s_waitcnt vmcnt(0)" ::: "memory");
    __syncthreads();
    if (threadIdx.x == 0) {
        unsigned* bar = b.bar;
        __builtin_amdgcn_s_waitcnt(0);
        unsigned nloc = b.st[0], nx = b.st[1];
        if (nloc == 0u) { xcd_barrier_complete(bar, b.x, nloc, nx); b.st[0] = nloc; b.st[1] = nx; }
        const unsigned old = xb_add(&bar[XB_XSUB(b.x)], 1u);
        const unsigned gen = old / nloc;
        if (old + 1u == (gen + 1u) * nloc) {
            __builtin_amdgcn_fence(__ATOMIC_RELEASE, "agent");
            asm volatile("s_waitcnt vmcnt(0)" ::: "memory");
            const unsigned og = xb_add(&bar[XB_TOP], 1u);
            const unsigned tg = og / nx;
            if (og + 1u == (tg + 1u) * nx) xb_add(&bar[XB_TOPGEN], 1u);
            else XB_SPIN(xb_ld(&bar[XB_TOPGEN]) == tg, bar);
            __builtin_amdgcn_fence(__ATOMIC_ACQUIRE, "agent");
            xb_add(&bar[XB_XGEN(b.x)], 1u);
            asm volatile("s_waitcnt vmcnt(0)" ::: "memory");
        } else {
            XB_SPIN(xb_ld(&bar[XB_XGEN(b.x)]) == gen, bar);
            __builtin_amdgcn_fence(__ATOMIC_ACQUIRE, "agent");
            asm volatile("s_waitcnt vmcnt(0)" ::: "memory");
        }
    }
    __syncthreads();
}
namespace pg8 {
#define PG8_LAS __attribute__((address_space(3)))
typedef unsigned short bf16_t;
typedef short bf16x8 __attribute__((ext_vector_type(8)));
typedef float f32x4 __attribute__((ext_vector_type(4)));
typedef unsigned u32x4 __attribute__((ext_vector_type(4)));
constexpr int BM = 256, BK = 64, HALF = 128, HTB = HALF * BK * 2  , STAGE_BYTES = 8 * HTB, NXCD = 8, WGM = 8;

__host__ __device__ __forceinline__ int lds_byte(int r, int c) { const int st = (r >> 4) * 2 + (c >> 5), rr = r & 15, cc = c & 31, ob = rr * 64 + cc * 2; return st * 1024 + (ob ^ (((ob >> 9) & 1) << 5)); }
__host__ __device__ __forceinline__ void stage_rc(int b, int& R, int& C) { const int st = b / 1024, sb = b % 1024, swz = sb ^ (((sb >> 9) & 1) << 5); R = (st >> 1) * 16 + swz / 64; C = (st & 1) * 32 + (swz % 64) / 2; }
__host__ __device__ __forceinline__ int perm32(int rho) { const int n = rho >> 4, i = rho & 15; return 8 * (i >> 2) + 4 * n + (i & 3); }

struct Unit { int pm, pn; };
struct Gemm { const bf16_t* A; const bf16_t* Bt; int M, N, K; };

struct StaticOrder {
    int nM, nN, nwg, G, c;
    __host__ __device__ void init(int M, int N, int G_, int c_) { nM = M / BM; nN = N / BM; nwg = nM * nN; G = G_; c = c_; }
    __host__ __device__ bool next(int i, Unit& u) const {
        const long L = (long)i * G + c; if (L >= nwg) return false;
        int wgid = (int)L; { const int q = nwg / NXCD, r = nwg % NXCD, xcd = wgid % NXCD, off = wgid / NXCD; wgid = (xcd < r ? xcd * (q + 1) : r * (q + 1) + (xcd - r) * q) + off; }
        const int nig = WGM * nN, gid = wgid / nig, fm = gid * WGM, gsz = (nM - fm) < WGM ? (nM - fm) : WGM;
        u.pm = fm + ((wgid % nig) % gsz); u.pn = (wgid % nig) / gsz; return true;
    }
    __device__ __forceinline__ void a_ready(const Unit&) const {}
    __device__ __forceinline__ void done(const Unit&) const {}
};
__device__ __forceinline__ unsigned cvt_pk_bf16(float lo, float hi) { unsigned r; asm volatile("v_cvt_pk_bf16_f32 %0, %1, %2" : "=v"(r) : "v"(lo), "v"(hi)); return r; }
template <class Epi, class Sched, bool ALIGN_EPI = false, bool SP2 = false>
__device__ __forceinline__ void gemm_phase(PG8_LAS unsigned char* lds, const Gemm g, const Sched& S, const Epi& E) {
    const int tid = ltid(), wid = __builtin_amdgcn_readfirstlane(tid >> 6), lane = tid & 63, wr = wid >> 2, wc = wid & 3, fr = lane & 15, fq = lane >> 4;
    const int K = g.K, nt = K / BK;
    unsigned voffA[2], voffB[2];
#pragma unroll
    for (int i = 0; i < 2; ++i) { int R, C; stage_rc(tid * 16 + i * 8192, R, C); const int Rb = Epi::PERM ? ((R & ~31) + perm32(R & 31)) : R;
        voffA[i] = (unsigned)(R * K + C) * 2u; voffB[i] = (unsigned)(Rb * K + C) * 2u; }
    const size_t kstep = (size_t)(BK * 2);
    const size_t hstep = (size_t)HALF * K * 2;
    const size_t tstep = 2 * hstep;
    const unsigned ldsw = (unsigned)wid * 1024u;
    const int aoff = lds_byte(wr * 64 + fr, fq * 8), boff = lds_byte(wc * 32 + fr, fq * 8);
#define PG8_SA(b, h) (((b) * 2 + (h)) * HTB)
#define PG8_SB(b, h) ((4 + (b) * 2 + (h)) * HTB)
#define PG8_STAGE(bufoff, gbase, voff) do { _Pragma("unroll") for (int _i = 0; _i < 2; ++_i) \
        __builtin_amdgcn_global_load_lds((const unsigned*)((const char*)(gbase) + (voff)[_i]), (PG8_LAS unsigned*)(lds + (bufoff) + ldsw + _i * 8192), 16, 0, 0); } while (0)
#define PG8_LDA(dst, b, h) do { _Pragma("unroll") for (int m = 0; m < 4; ++m) _Pragma("unroll") for (int k = 0; k < 2; ++k) dst[m][k] = *(const PG8_LAS bf16x8*)(lds + PG8_SA(b, h) + aoff + m * 2048 + k * 1024); } while (0)
#define PG8_LDB(dst, b, h) do { _Pragma("unroll") for (int n = 0; n < 2; ++n) _Pragma("unroll") for (int k = 0; k < 2; ++k) dst[n][k] = *(const PG8_LAS bf16x8*)(lds + PG8_SB(b, h) + boff + n * 2048 + k * 1024); } while (0)
#define PG8_MMA(ai, bj, At, Bt) do { __builtin_amdgcn_s_setprio(1); _Pragma("unroll") for (int m = 0; m < 4; ++m) _Pragma("unroll") for (int n = 0; n < 2; ++n) _Pragma("unroll") for (int k = 0; k < 2; ++k) \
        acc[ai][bj][m][n] = __builtin_amdgcn_mfma_f32_16x16x32_bf16(Bt[n][k], At[m][k], acc[ai][bj][m][n], 0, 0, 0); __builtin_amdgcn_s_setprio(0); } while (0)
#define PG8_WAIT_V(n) asm volatile("s_waitcnt vmcnt(" #n ")" ::: "memory")
#define PG8_WAIT_L(n) asm volatile("s_waitcnt lgkmcnt(" #n ")" ::: "memory")
#define PG8_BAR __builtin_amdgcn_s_barrier()
#define PG8_SCHED __builtin_amdgcn_sched_barrier(0)
    Unit cur, nxt; int ui = 0;
    if (!S.next(0, cur)) return;
    f32x4 acc[2][2][4][2];
#pragma unroll
    for (int a = 0; a < 2; ++a)
#pragma unroll
        for (int b = 0; b < 2; ++b)
#pragma unroll
            for (int m = 0; m < 4; ++m)
#pragma unroll
                for (int n = 0; n < 2; ++n) acc[a][b][m][n] = (f32x4){0.f, 0.f, 0.f, 0.f};
    bf16x8 At[4][2], B0[2][2], B1[2][2];
    const char* cA = (const char*)g.A + (size_t)cur.pm * tstep; const char* cB = (const char*)g.Bt + (size_t)cur.pn * tstep;
    S.a_ready(cur);
    if constexpr (SP2) {
        PG8_STAGE(PG8_SB(0, 0), cB, voffB); PG8_STAGE(PG8_SB(0, 1), cB + hstep, voffB); PG8_STAGE(PG8_SA(0, 0), cA, voffA); PG8_STAGE(PG8_SA(0, 1), cA + hstep, voffA);
        if (wr == 1) PG8_BAR;
        PG8_WAIT_V(2); PG8_BAR;
        PG8_STAGE(PG8_SB(1, 0), cB + kstep, voffB); PG8_STAGE(PG8_SA(1, 0), cA + kstep, voffA); PG8_STAGE(PG8_SB(1, 1), cB + hstep + kstep, voffB);
        PG8_WAIT_V(6); PG8_BAR;
    } else {
        PG8_STAGE(PG8_SB(0, 0), cB, voffB); PG8_STAGE(PG8_SA(0, 0), cA, voffA); PG8_STAGE(PG8_SB(0, 1), cB + hstep, voffB); PG8_STAGE(PG8_SA(0, 1), cA + hstep, voffA);
        if (wr == 1) PG8_BAR;
        PG8_WAIT_V(4); PG8_BAR;
        PG8_STAGE(PG8_SB(1, 0), cB + kstep, voffB); PG8_STAGE(PG8_SA(1, 0), cA + kstep, voffA); PG8_STAGE(PG8_SB(1, 1), cB + hstep + kstep, voffB);
        PG8_WAIT_V(6); PG8_BAR;
    }
    for (;;) {
        const bool has_next = S.next(ui + 1, nxt);
        const char* nA = has_next ? (const char*)g.A + (size_t)nxt.pm * tstep : cA; const char* nB = has_next ? (const char*)g.Bt + (size_t)nxt.pn * tstep : cB;
        for (int t = 0; t < nt; t += 2) {
            const bool last = (t == nt - 2);
            const char* a1 = cA + (size_t)(t + 1) * kstep;
            const char* a2 = last ? nA : cA + (size_t)(t + 2) * kstep; const char* b2 = last ? nB : cB + (size_t)(t + 2) * kstep;
            const char* a3 = a2 + kstep; const char* b3 = b2 + kstep;
            if (last && has_next) S.a_ready(nxt);
            if constexpr (SP2) {
            PG8_LDB(B0, 0, 0); PG8_LDB(B1, 0, 1); PG8_SCHED; PG8_LDA(At, 0, 0); PG8_STAGE(PG8_SA(1, 1), a1 + hstep, voffA);
            PG8_WAIT_V(8); PG8_WAIT_L(0); PG8_BAR; PG8_MMA(0, 0, At, B0); PG8_MMA(0, 1, At, B1); PG8_BAR; PG8_SCHED;
            PG8_LDA(At, 0, 1); PG8_STAGE(PG8_SB(0, 0), b2, voffB); PG8_STAGE(PG8_SB(0, 1), b2 + hstep, voffB); PG8_STAGE(PG8_SA(0, 0), a2, voffA);
            PG8_WAIT_V(8); PG8_WAIT_L(0); PG8_BAR; PG8_MMA(1, 0, At, B0); PG8_MMA(1, 1, At, B1); PG8_BAR; PG8_SCHED;
            PG8_LDB(B0, 1, 0); PG8_LDB(B1, 1, 1); PG8_SCHED; PG8_LDA(At, 1, 0); PG8_STAGE(PG8_SA(0, 1), a2 + hstep, voffA);
            PG8_WAIT_V(8); PG8_WAIT_L(0); PG8_BAR; PG8_MMA(0, 0, At, B0); PG8_MMA(0, 1, At, B1); PG8_BAR; PG8_SCHED;
            PG8_LDA(At, 1, 1); PG8_STAGE(PG8_SB(1, 0), b3, voffB); PG8_STAGE(PG8_SB(1, 1), b3 + hstep, voffB); PG8_STAGE(PG8_SA(1, 0), a3, voffA);
            PG8_WAIT_V(8); PG8_WAIT_L(0); PG8_BAR; PG8_MMA(1, 0, At, B0); PG8_MMA(1, 1, At, B1); PG8_BAR; PG8_SCHED;
            } else {
            PG8_LDB(B0, 0, 0); PG8_SCHED; PG8_LDA(At, 0, 0); PG8_STAGE(PG8_SA(1, 1), a1 + hstep, voffA);
            PG8_WAIT_L(8); PG8_BAR; PG8_WAIT_L(0); PG8_MMA(0, 0, At, B0); PG8_BAR; PG8_SCHED;
            PG8_LDB(B1, 0, 1); PG8_STAGE(PG8_SB(0, 0), b2, voffB);
            PG8_BAR; PG8_WAIT_L(0); PG8_MMA(0, 1, At, B1); PG8_BAR;
            PG8_LDA(At, 0, 1); PG8_STAGE(PG8_SA(0, 0), a2, voffA);
            PG8_BAR; PG8_WAIT_L(0); PG8_MMA(1, 0, At, B0); PG8_BAR; PG8_SCHED;
            PG8_STAGE(PG8_SB(0, 1), b2 + hstep, voffB);
            PG8_WAIT_V(6); PG8_BAR; PG8_MMA(1, 1, At, B1); PG8_BAR;
            PG8_LDB(B0, 1, 0); PG8_SCHED; PG8_LDA(At, 1, 0); PG8_STAGE(PG8_SA(0, 1), a2 + hstep, voffA);
            PG8_WAIT_L(8); PG8_BAR; PG8_WAIT_L(0); PG8_MMA(0, 0, At, B0); PG8_BAR; PG8_SCHED;
            PG8_LDB(B1, 1, 1); PG8_STAGE(PG8_SB(1, 0), b3, voffB);
            PG8_BAR; PG8_WAIT_L(0); PG8_MMA(0, 1, At, B1); PG8_BAR;
            PG8_LDA(At, 1, 1); PG8_STAGE(PG8_SA(1, 0), a3, voffA);
            PG8_BAR; PG8_WAIT_L(0); PG8_MMA(1, 0, At, B0); PG8_BAR; PG8_SCHED;
            PG8_STAGE(PG8_SB(1, 1), b3 + hstep, voffB);
            PG8_WAIT_V(6); PG8_BAR; PG8_MMA(1, 1, At, B1); PG8_BAR;
            }
        }
        if constexpr (ALIGN_EPI) { if (wr == 0) PG8_BAR; }
        if constexpr (!Epi::AFTER_DRAIN) { E(acc, cur, wr, wc, fr, fq); S.done(cur); }
        if (!has_next) break;
#pragma unroll
        for (int a = 0; a < 2; ++a)
#pragma unroll
            for (int b = 0; b < 2; ++b)
#pragma unroll
                for (int m = 0; m < 4; ++m)
#pragma unroll
                    for (int n = 0; n < 2; ++n) acc[a][b][m][n] = (f32x4){0.f, 0.f, 0.f, 0.f};
        cur = nxt; cA = nA; cB = nB; ++ui;
        if constexpr (ALIGN_EPI) { if (wr == 1) PG8_BAR; }
    }
    PG8_WAIT_V(0);
    if constexpr (!ALIGN_EPI) { if (wr == 0) PG8_BAR; }
    PG8_BAR;
    if constexpr (Epi::AFTER_DRAIN) { E.fused(acc, cur, wr, wc, fr, fq, lds, wid, lane); S.done(cur); }
#undef PG8_SA
#undef PG8_SB
#undef PG8_STAGE
#undef PG8_LDA
#undef PG8_LDB
#undef PG8_MMA
#undef PG8_WAIT_V
#undef PG8_WAIT_L
#undef PG8_BAR
#undef PG8_SCHED
}
}
using pg8::bf16_t; using pg8::bf16x8; using pg8::f32x4; using pg8::u32x4;
typedef unsigned u32x2 __attribute__((ext_vector_type(2)));

constexpr int SEQ = 8192, NTOK = 32768;
constexpr int LDS_BYTES = 160 * 1024;
constexpr size_t WS_WBT  = 0;
constexpr size_t WS_WOT  = WS_WBT + (size_t)2 * 8224 * 1024 * 2;
constexpr size_t WS_HID  = WS_WOT + (size_t)2 * 1024 * 2048 * 2;
constexpr size_t WS_XN   = WS_HID + (size_t)2 * 8192 * 64 * 4;
constexpr size_t WS_SPEC = WS_XN + (size_t)32768 * 1024 * 2;
constexpr size_t WS_Y    = WS_SPEC + (size_t)32768 * 32 * 4;
constexpr size_t WS_PROJ = WS_Y + (size_t)32768 * 2048 * 2;
constexpr size_t WS_AUX  = WS_PROJ + (size_t)32768 * 2560 * 2;
constexpr size_t WS_ATOT = WS_AUX + (size_t)3 * 512 * 32768 * 2;
constexpr size_t WS_BAR  = WS_ATOT + 65536;
constexpr size_t WS_END  = WS_BAR + 16384;

struct Params { const float* in[27]; float* out; unsigned char* ws; };
#define KPR const __attribute__((address_space(4))) Params&
__device__ __forceinline__ const __attribute__((address_space(4))) Params* kp() { auto k = __builtin_amdgcn_kernarg_segment_ptr(); asm volatile("" : "+s"(k)); return (const __attribute__((address_space(4))) Params*)k; }
enum { I_X = 0, I_NORMW, I_WIN, I_WOUT, I_HYCW, I_HYCB, I_HYW1, I_HYB1, I_HYW2, I_HYB2, I_HYW3, I_HYFREQ, I_HYDECAY, I_HYSKIP, I_MBCW, I_MBCB, I_MBDTB, I_MBALOG, I_MBD, I_MBNW,
       I_MLCW, I_MLCB, I_MLGB, I_MLNW, I_NAQN, I_NAKN, I_NARPB };

__device__ __forceinline__ float bf2f(bf16_t b) { return __uint_as_float(((unsigned)b) << 16); }
typedef __bf16 bf16v2_t __attribute__((ext_vector_type(2)));
__device__ __forceinline__ unsigned pk2(float lo, float hi) { bf16v2_t v; v[0] = (__bf16)lo; v[1] = (__bf16)hi; return __builtin_bit_cast(unsigned, v); }
__device__ __forceinline__ bf16_t f2bf(float f) { return __builtin_bit_cast(bf16_t, (__bf16)f); }
template <int E> __device__ __forceinline__ float bfe(const u32x4& u) { const unsigned w = u[E >> 1]; return (E & 1) ? __uint_as_float(w & 0xffff0000u) : __uint_as_float(w << 16); }
__device__ __forceinline__ void unpack8(const u32x4& u, float (&v)[8]) { v[0] = bfe<0>(u); v[1] = bfe<1>(u); v[2] = bfe<2>(u); v[3] = bfe<3>(u); v[4] = bfe<4>(u); v[5] = bfe<5>(u); v[6] = bfe<6>(u); v[7] = bfe<7>(u); }
__device__ __forceinline__ u32x4 pack8(const float (&v)[8]) { u32x4 w; w.x = pk2(v[0], v[1]); w.y = pk2(v[2], v[3]); w.z = pk2(v[4], v[5]); w.w = pk2(v[6], v[7]); return w; }
__device__ __forceinline__ float rcp_f(float x) { return __builtin_amdgcn_rcpf(x); }
typedef __bf16 bf16v2d_t __attribute__((ext_vector_type(2)));
__device__ __forceinline__ float sumsq8(const u32x4& u, float acc) {
    acc = __builtin_amdgcn_fdot2_f32_bf16(__builtin_bit_cast(bf16v2d_t, u.x), __builtin_bit_cast(bf16v2d_t, u.x), acc, false); acc = __builtin_amdgcn_fdot2_f32_bf16(__builtin_bit_cast(bf16v2d_t, u.y), __builtin_bit_cast(bf16v2d_t, u.y), acc, false);
    acc = __builtin_amdgcn_fdot2_f32_bf16(__builtin_bit_cast(bf16v2d_t, u.z), __builtin_bit_cast(bf16v2d_t, u.z), acc, false); acc = __builtin_amdgcn_fdot2_f32_bf16(__builtin_bit_cast(bf16v2d_t, u.w), __builtin_bit_cast(bf16v2d_t, u.w), acc, false); return acc; }
__device__ __forceinline__ float silu_f(float x) { return x * rcp_f(1.0f + __expf(-x)); }
__device__ __forceinline__ float sigmoid_f(float x) { return rcp_f(1.0f + __expf(-x)); }
__device__ __forceinline__ f32x4 mfma16(const bf16x8& a, const bf16x8& b, const f32x4& c) { return __builtin_amdgcn_mfma_f32_16x16x32_bf16(a, b, c, 0, 0, 0); }
__device__ __forceinline__ bf16x8 as_bf16x8(const u32x4& u) { union { u32x4 a; bf16x8 b; } x; x.a = u; return x.b; }
__device__ __forceinline__ int clampi(int v, int lo, int hi) { return v < lo ? lo : (v > hi ? hi : v); }

struct EpiProj {
    static constexpr bool PERM = true, AFTER_DRAIN = false;
    bf16_t* O; int ldc;
    __device__ __forceinline__ void operator()(const f32x4 (&acc)[2][2][4][2], const pg8::Unit& u, int wr, int wc, int fr, int fq) const {
        const int row0 = u.pm * 256 + wr * 64 + fr, col0 = u.pn * 256 + wc * 32 + 8 * fq;
#pragma unroll
        for (int ai = 0; ai < 2; ++ai)
#pragma unroll
            for (int m = 0; m < 4; ++m) { bf16_t* rowp = O + (size_t)(row0 + ai * 128 + m * 16) * ldc + col0;
#pragma unroll
                for (int bj = 0; bj < 2; ++bj) { const f32x4 v0 = acc[ai][bj][m][0], v1 = acc[ai][bj][m][1];
                    u32x4 w; w.x = pk2(v0[0], v0[1]); w.y = pk2(v0[2], v0[3]); w.z = pk2(v1[0], v1[1]); w.w = pk2(v1[2], v1[3]);
                    *(u32x4*)(rowp + bj * 128) = w; } }
    }
};
struct EpiResid {
    static constexpr bool PERM = false, AFTER_DRAIN = false;
    float* C; const float* R; int ldc;
    __device__ __forceinline__ void operator()(const f32x4 (&acc)[2][2][4][2], const pg8::Unit& u, int wr, int wc, int fr, int fq) const {
        const int row0 = u.pm * 256 + wr * 64 + fr, col0 = u.pn * 256 + wc * 32 + 4 * fq;
#pragma unroll
        for (int ai = 0; ai < 2; ++ai)
#pragma unroll
            for (int mp = 0; mp < 2; ++mp) { f32x4 rv[2][2][2];
#pragma unroll
                for (int mm = 0; mm < 2; ++mm) { const size_t off = (size_t)(row0 + ai * 128 + (mp * 2 + mm) * 16) * ldc + col0;
#pragma unroll
                    for (int bj = 0; bj < 2; ++bj)
#pragma unroll
                        for (int n = 0; n < 2; ++n) rv[mm][bj][n] = *(const f32x4*)(R + off + bj * 128 + n * 16); }
                asm volatile("" ::: "memory");
#pragma unroll
                for (int mm = 0; mm < 2; ++mm) { const size_t off = (size_t)(row0 + ai * 128 + (mp * 2 + mm) * 16) * ldc + col0;
#pragma unroll
                    for (int bj = 0; bj < 2; ++bj)
#pragma unroll
                        for (int n = 0; n < 2; ++n) *(f32x4*)(C + off + bj * 128 + n * 16) = rv[mm][bj][n] + acc[ai][bj][mp * 2 + mm][n]; }
                asm volatile("" ::: "memory"); }
    }
};
template <class Epi> __device__ __forceinline__ void run_gemm(unsigned char* smem, const bf16_t* A, const bf16_t* Bt, int M, int N, int K, const Epi& E) {
    pg8::Gemm g{A, Bt, M, N, K}; pg8::StaticOrder S; S.init(M, N, (int)gridDim.x, (int)blockIdx.x);
    pg8::gemm_phase<Epi, pg8::StaticOrder, true, true>((PG8_LAS unsigned char*)smem, g, S, E);
    __syncthreads();
}

__device__ __forceinline__ int win_col(int n) { return n < 3584 ? n : (n < 6144 ? n + 16 : (n < 8192 ? n + 32 : (n < 8208 ? n - 8192 + 3584 : n - 8208 + 6160))); }
__device__ __forceinline__ void conv_wt(const float* W, int K, int ldw, bf16_t* Bt, int nrows, int mapmode, unsigned char* smem) {
    float* tile = (float*)smem;
    const int tid = ltid(), ntn = nrows / 32, ntk = K / 128, ntot = ntn * ntk;
    for (int t0 = blockIdx.x * 4; t0 < ntot; t0 += gridDim.x * 4) {
        float v[4][8];
#pragma unroll
        for (int q = 0; q < 4; ++q) { const int t = t0 + q < ntot ? t0 + q : ntot - 1, tn = t % ntn, tk = t / ntn, n0 = tn * 32, k0 = tk * 128;
            const int nn = tid & 31, kk = tid >> 5, col = mapmode ? win_col(n0 + nn) : (n0 + nn);
#pragma unroll
            for (int i = 0; i < 8; ++i) v[q][i] = W[(size_t)(k0 + kk + 16 * i) * ldw + col]; }
#pragma unroll
        for (int q = 0; q < 4; ++q) { const int nn = tid & 31, kk = tid >> 5;
#pragma unroll
            for (int i = 0; i < 8; ++i) tile[q * 4128 + nn * 129 + kk + 16 * i] = v[q][i]; }
        __syncthreads();
#pragma unroll
        for (int q = 0; q < 4; ++q) if (t0 + q < ntot) { const int t = t0 + q, tn = t % ntn, tk = t / ntn, n0 = tn * 32, k0 = tk * 128; const int row = tid >> 4, kq = tid & 15; float o[8];
#pragma unroll
            for (int e = 0; e < 8; ++e) o[e] = tile[q * 4128 + row * 129 + kq * 8 + e];
            *(u32x4*)(Bt + (size_t)(n0 + row) * K + k0 + kq * 8) = pack8(o); }
        __syncthreads();
    }
}
__device__ __forceinline__ void hid_phase(KPR p, unsigned char* smem) {
    float* sF = (float*)smem; float* sH = sF + 8 * 20;
    float* hid = (float*)(p.ws + WS_HID);
    const int tid = ltid(), r = tid >> 6, j = tid & 63;
    int curl = -1; float w1r[17], w2r[64], fq = 0.f, b1 = 0.f, b2 = 0.f;
    for (int it = blockIdx.x; it < 2048; it += gridDim.x) {
        const int row = it * 8 + r, l = row >> 13, t = row & 8191;
        if (l != curl) { curl = l; fq = p.in[I_HYFREQ][l * 64 + j]; b1 = p.in[I_HYB1][l * 64 + j]; b2 = p.in[I_HYB2][l * 64 + j];
#pragma unroll
            for (int i = 0; i < 17; ++i) w1r[i] = p.in[I_HYW1][l * 17 * 64 + i * 64 + j];
#pragma unroll
            for (int k = 0; k < 64; ++k) w2r[k] = p.in[I_HYW2][l * 64 * 64 + k * 64 + j]; }
        if (j < 17) { float v;
            if (j == 0) v = (float)t * (1.0f / 8192.0f);
            else { const int band = (j <= 8) ? j : j - 8; const float fr = (float)((t * band) & 8191) * (1.0f / 8192.0f); v = (j <= 8) ? __builtin_amdgcn_cosf(fr) : __builtin_amdgcn_sinf(fr); }
            sF[r * 20 + j] = v; }
        __syncthreads();
        { float a = b1;
#pragma unroll
          for (int i = 0; i < 17; ++i) a += sF[r * 20 + i] * w1r[i];
          sH[r * 64 + j] = __sinf(fq * a); }
        __syncthreads();
        { float a = b2;
#pragma unroll
          for (int k4 = 0; k4 < 16; ++k4) { const f32x4 hv = *(const f32x4*)(sH + r * 64 + k4 * 4); a += hv[0] * w2r[k4 * 4] + hv[1] * w2r[k4 * 4 + 1] + hv[2] * w2r[k4 * 4 + 2] + hv[3] * w2r[k4 * 4 + 3]; }
          hid[((size_t)(l * 64 + j)) * 8192 + t] = __sinf(fq * a); }
    }
}

__device__ __forceinline__ void norm_phase(const float* xin, const float* nw, const bf16_t* wsp, bf16_t* xn, float* spec, unsigned char* smem) {
    bf16_t* sA = (bf16_t*)smem;
    const int tid = ltid(), wid = tid >> 6, lane = tid & 63;
    f32x4 nwv[4];
#pragma unroll
    for (int i = 0; i < 4; ++i) nwv[i] = *(const f32x4*)(nw + lane * 4 + 256 * i);
    for (int it = blockIdx.x; it < 512; it += gridDim.x) {
        const int row0 = it * 64;
#pragma unroll 1
        for (int rb = 0; rb < 2; ++rb) {
            f32x4 v[4][4];
#pragma unroll
            for (int rr = 0; rr < 4; ++rr) { const float* xr = xin + (size_t)(row0 + wid * 8 + rb * 4 + rr) * 1024;
#pragma unroll
                for (int i = 0; i < 4; ++i) v[rr][i] = *(const f32x4*)(xr + lane * 4 + 256 * i); }
#pragma unroll
            for (int rr = 0; rr < 4; ++rr) { const int r = wid * 8 + rb * 4 + rr; float ss = 0.f;
#pragma unroll
                for (int i = 0; i < 4; ++i) ss += v[rr][i][0] * v[rr][i][0] + v[rr][i][1] * v[rr][i][1] + v[rr][i][2] * v[rr][i][2] + v[rr][i][3] * v[rr][i][3];
#pragma unroll
                for (int d = 32; d >= 1; d >>= 1) ss += __shfl_xor(ss, d);
                const float rstd = rsqrtf(ss * (1.0f / 1024.0f) + 1e-6f);
#pragma unroll
                for (int i = 0; i < 4; ++i) { const f32x4 w = nwv[i]; u32x2 o; o.x = pk2(v[rr][i][0] * rstd * w[0], v[rr][i][1] * rstd * w[1]); o.y = pk2(v[rr][i][2] * rstd * w[2], v[rr][i][3] * rstd * w[3]);
                    *(u32x2*)(xn + (size_t)(row0 + r) * 1024 + lane * 4 + 256 * i) = o; *(u32x2*)(sA + r * 1032 + lane * 4 + 256 * i) = o; } }
        }
        __syncthreads();
        { const int rt = wid >> 1, ct = wid & 1; f32x4 acc = {0.f, 0.f, 0.f, 0.f};
          const bf16_t* ap = sA + (rt * 16 + (lane & 15)) * 1032 + 8 * (lane >> 4); const bf16_t* bp = wsp + (size_t)(ct * 16 + (lane & 15)) * 1024 + 8 * (lane >> 4);
#pragma unroll 8
          for (int ks = 0; ks < 32; ++ks) acc = mfma16(*(const bf16x8*)(ap + ks * 32), *(const bf16x8*)(bp + ks * 32), acc);
#pragma unroll
          for (int j = 0; j < 4; ++j) spec[(size_t)(row0 + rt * 16 + 4 * (lane >> 4) + j) * 32 + ct * 16 + (lane & 15)] = acc[j]; }
        __syncthreads();
    }
}
template <bool CONV, int NCOLS>
__device__ __forceinline__ void load_chunk(bf16_t* dst, int dstride, const bf16_t* proj, int ld, int tok0, int tpos0, int col0, const float* cw, const float* cb, int cwn, int ch0, float scale) {
    constexpr int NGRP = NCOLS / 8, NT = 128 * NGRP / 512, BT = NT < 4 ? NT : 4;
    const int tid = ltid();
    f32x4 wq[4][2];
    if (CONV) { const int cg0 = ch0 + (tid % NGRP) * 8;
#pragma unroll
        for (int k = 0; k < 3; ++k) { wq[k][0] = *(const f32x4*)(cw + k * cwn + cg0); wq[k][1] = *(const f32x4*)(cw + k * cwn + cg0 + 4); }
        wq[3][0] = *(const f32x4*)(cb + cg0); wq[3][1] = *(const f32x4*)(cb + cg0 + 4); }
#pragma unroll 1
    for (int bt = 0; bt < NT / BT; ++bt) {
        u32x4 u0[BT], u1[BT], u2[BT];
#pragma unroll
        for (int i = 0; i < BT; ++i) { const int task = tid + 512 * (bt * BT + i), r = task / NGRP, cgp = task % NGRP;
            const bf16_t* pp = proj + (size_t)(tok0 + r) * ld + col0 + cgp * 8;
            u1[i] = *(const u32x4*)pp;
            if (CONV) { const bool hp = (tpos0 + r > 0), hn = (tpos0 + r < SEQ - 1); u0[i] = *(const u32x4*)(pp - (hp ? ld : 0)); u2[i] = *(const u32x4*)(pp + (hn ? ld : 0)); } }
#pragma unroll
        for (int i = 0; i < BT; ++i) { const int task = tid + 512 * (bt * BT + i), r = task / NGRP, cgp = task % NGRP; float v[8];
            if (CONV) { float x0[8], x1[8], x2[8]; const float mp = (tpos0 + r > 0) ? 1.0f : 0.0f, mn = (tpos0 + r < SEQ - 1) ? 1.0f : 0.0f;
                unpack8(u0[i], x0); unpack8(u1[i], x1); unpack8(u2[i], x2);
#pragma unroll
                for (int e = 0; e < 8; ++e) { x0[e] *= mp; x2[e] *= mn; }
#pragma unroll
                for (int e = 0; e < 8; ++e) { const float t = wq[3][e >> 2][e & 3] + wq[0][e >> 2][e & 3] * x0[e] + wq[1][e >> 2][e & 3] * x1[e] + wq[2][e >> 2][e & 3] * x2[e]; v[e] = silu_f(t) * scale; }
            } else { unpack8(u1[i], v);
#pragma unroll
                for (int e = 0; e < 8; ++e) v[e] *= scale; }
            *(u32x4*)(dst + r * dstride + cgp * 8) = pack8(v); }
    }
}
template <int STRIDE> __device__ __forceinline__ void tr_frags4(bf16x8 (&f)[4], const bf16_t* tile, int col0) {
    const int lane = ltid() & 63, g = lane >> 4, q = (lane & 15) >> 2, pp = lane & 3;
    const unsigned a = (unsigned)(size_t)(tile + (8 * g + q) * STRIDE + col0) + 8u * pp;
    u32x2 r0, r1, r2, r3, r4, r5, r6, r7;
    asm volatile("ds_read_b64_tr_b16 %0, %8 offset:%9\n\tds_read_b64_tr_b16 %1, %8 offset:%10\n\tds_read_b64_tr_b16 %2, %8 offset:%11\n\tds_read_b64_tr_b16 %3, %8 offset:%12\n\t"
                 "ds_read_b64_tr_b16 %4, %8 offset:%13\n\tds_read_b64_tr_b16 %5, %8 offset:%14\n\tds_read_b64_tr_b16 %6, %8 offset:%15\n\tds_read_b64_tr_b16 %7, %8 offset:%16\n\ts_waitcnt lgkmcnt(0)"
                 : "=&v"(r0), "=&v"(r1), "=&v"(r2), "=&v"(r3), "=&v"(r4), "=&v"(r5), "=&v"(r6), "=&v"(r7)
                 : "v"(a), "i"(0 * STRIDE * 2), "i"(4 * STRIDE * 2), "i"(32 * STRIDE * 2), "i"(36 * STRIDE * 2), "i"(64 * STRIDE * 2), "i"(68 * STRIDE * 2), "i"(96 * STRIDE * 2), "i"(100 * STRIDE * 2) : "memory");
    f[0] = as_bf16x8((u32x4){r0.x, r0.y, r1.x, r1.y}); f[1] = as_bf16x8((u32x4){r2.x, r2.y, r3.x, r3.y}); f[2] = as_bf16x8((u32x4){r4.x, r4.y, r5.x, r5.y}); f[3] = as_bf16x8((u32x4){r6.x, r6.y, r7.x, r7.y});
}
__device__ __forceinline__ bf16x8 gather8(const bf16_t* base, int stride) {
    bf16x8 r;
#pragma unroll
    for (int e = 0; e < 8; ++e) r[e] = (short)base[e * stride];
    return r;
}
__device__ __forceinline__ void lds_transpose(const bf16_t* src, int sstride, bf16_t* dst, int ncols) {
    for (int task = ltid(); task < 16 * ncols; task += 512) { const int c = task % ncols, rg = task / ncols; u32x4 w;
        const bf16_t* sp = src + (rg * 8) * sstride + c;
        w.x = (unsigned)sp[0] | ((unsigned)sp[sstride] << 16); w.y = (unsigned)sp[2 * sstride] | ((unsigned)sp[3 * sstride] << 16);
        w.z = (unsigned)sp[4 * sstride] | ((unsigned)sp[5 * sstride] << 16); w.w = (unsigned)sp[6 * sstride] | ((unsigned)sp[7 * sstride] << 16);
        *(u32x4*)(dst + c * 136 + rg * 8) = w; }
}
template <int MODE>
__device__ __forceinline__ void decay_prep(KPR p, int layer, int hdl, int headg, int dir, int tok0, float* sE, float* sWv, float* sWgt, float* sTot) {
    const int lane = ltid() & 63; const float* spec = (const float*)(p.ws + WS_SPEC);
    const int u0 = 2 * lane, u1 = u0 + 1, s0 = dir ? 127 - u0 : u0, s1 = dir ? 127 - u1 : u1;
    float a0, a1, w0, w1;
    if (MODE == 0) {
        const float bias = p.in[I_MBDTB][layer * 16 + dir * 8 + headg], A = -__expf(p.in[I_MBALOG][layer * 16 + dir * 8 + headg]);
        const float r0 = spec[(size_t)(tok0 + s0) * 32 + dir * 8 + headg] + bias, r1 = spec[(size_t)(tok0 + s1) * 32 + dir * 8 + headg] + bias;
        w0 = r0 > 20.f ? r0 : log1pf(__expf(r0)); w1 = r1 > 20.f ? r1 : log1pf(__expf(r1)); a0 = w0 * A; a1 = w1 * A;
    } else {
        const float bi = p.in[I_MLGB][layer * 16 + dir * 8 + headg], bf = p.in[I_MLGB][layer * 16 + dir * 8 + 4 + headg];
        const float i0 = spec[(size_t)(tok0 + s0) * 32 + 16 + dir * 8 + headg] + bi, i1 = spec[(size_t)(tok0 + s1) * 32 + 16 + dir * 8 + headg] + bi;
        const float f0 = spec[(size_t)(tok0 + s0) * 32 + 16 + dir * 8 + 4 + headg] + bf, f1 = spec[(size_t)(tok0 + s1) * 32 + 16 + dir * 8 + 4 + headg] + bf;
        w0 = __expf(i0); w1 = __expf(i1);
        a0 = fminf(f0, 0.f) - log1pf(__expf(-fabsf(f0))); a1 = fminf(f1, 0.f) - log1pf(__expf(-fabsf(f1)));
    }
    const float pr = a0 + a1; float incl = pr;
#pragma unroll
    for (int d = 1; d < 64; d <<= 1) { const float t = __shfl_up(incl, d); if (lane >= d) incl += t; }
    const float e0 = incl - pr + a0, e1 = incl, tot = __shfl(incl, 63);
    sE[hdl * 128 + s0] = e0; sE[hdl * 128 + s1] = e1; sWv[hdl * 128 + s0] = w0; sWv[hdl * 128 + s1] = w1;
    if (sWgt) { sWgt[hdl * 128 + s0] = __expf(tot - e0) * w0; sWgt[hdl * 128 + s1] = __expf(tot - e1) * w1; if (lane == 0) sTot[hdl] = tot; }
}

template <int MODE> struct SsdCfg;
template <> struct SsdCfg<0> { static constexpr int NH = 4, PT = 4, PP = 64, NHT = 8, LD = 1536, NITEM = 512, PTO = 4; };
template <> struct SsdCfg<1> { static constexpr int NH = 1, PT = 9, PP = 144, NHT = 4, LD = 2560, NITEM = 1024, PTO = 8; };

template <int MODE>
__device__ __forceinline__ void ssd_m1(KPR p, int layer, unsigned char* smem) {
    typedef SsdCfg<MODE> C;
    constexpr int XS = (MODE == 0) ? 264 : 152;
    bf16_t* sBm = (bf16_t*)smem; bf16_t* sX = sBm + 128 * 136;
    float* sE = (float*)(smem + 34816 + 67584); float* sWv = sE + 1024; float* sWgt = sWv + 1024; float* sTot = sWgt + 1024;
    const bf16_t* proj = (const bf16_t*)(p.ws + WS_PROJ); bf16_t* ST = (bf16_t*)(p.ws + WS_AUX); float* atot = (float*)(p.ws + WS_ATOT);
    const int tid = ltid(), wid = tid >> 6, lane = tid & 63, lr = lane & 15, lq = lane >> 4;
    const float* cw = p.in[MODE == 0 ? I_MBCW : I_MLCW] + layer * 3 * 1024; const float* cb = p.in[MODE == 0 ? I_MBCB : I_MLCB] + layer * 1024;
    for (int it = blockIdx.x; it < C::NITEM; it += gridDim.x) {
        int g, c, b;
        if (MODE == 0) { g = it & 1; c = (it >> 1) & 63; b = it >> 7; } else { g = it & 3; c = (it >> 2) & 63; b = it >> 8; }
        const int tok0 = b * SEQ + c * 128, tpos0 = c * 128;
        load_chunk<true, 128>(sBm, 136, proj, C::LD, tok0, tpos0, 512 + g * 128, cw, cb, 1024, 512 + g * 128, MODE == 0 ? 1.0f : 0.08838834764831845f);
        if (MODE == 0) { load_chunk<true, 128>(sX, XS, proj, C::LD, tok0, tpos0, g * 256, cw, cb, 1024, g * 256, 1.0f); load_chunk<true, 128>(sX + 128, XS, proj, C::LD, tok0, tpos0, g * 256 + 128, cw, cb, 1024, g * 256 + 128, 1.0f); }
        else { load_chunk<false, 128>(sX, XS, proj, C::LD, tok0, tpos0, 1024 + g * 128, cw, cb, 1024, 0, 1.0f);
            for (int idx = tid; idx < 128 * 16; idx += 512) sX[(idx >> 4) * XS + 128 + (idx & 15)] = ((idx & 15) == 0) ? (bf16_t)0x3F80 : (bf16_t)0; }
        if (wid < 2 * C::NH) { const int hl = wid >> 1, dir = wid & 1, headg = (MODE == 0) ? g * 4 + hl : g; decay_prep<MODE>(p, layer, wid, headg, dir, tok0, sE, sWv, sWgt, sTot); }
        __syncthreads();
        for (int t = wid; t < C::NH * 2 * C::PT; t += 8) {
            const int hdl = t % (2 * C::NH), pt = t / (2 * C::NH), hl = hdl >> 1, dir = hdl & 1, headg = (MODE == 0) ? g * 4 + hl : g;
            bf16x8 bfr[4]; tr_frags4<XS>(bfr, sX, hl * C::PP + pt * 16);
#pragma unroll
            for (int ks = 0; ks < 4; ++ks) { const int sb = ks * 32 + 8 * lq; float v[8]; union { bf16x8 b; u32x4 u; } cv; cv.b = bfr[ks]; unpack8(cv.u, v);
                const f32x4 w0 = *(const f32x4*)(sWgt + hdl * 128 + sb), w1 = *(const f32x4*)(sWgt + hdl * 128 + sb + 4);
                v[0] *= w0[0]; v[1] *= w0[1]; v[2] *= w0[2]; v[3] *= w0[3]; v[4] *= w1[0]; v[5] *= w1[1]; v[6] *= w1[2]; v[7] *= w1[3];
                bfr[ks] = as_bf16x8(pack8(v)); }
            const int seq = (b * C::NHT + headg) * 2 + dir;
            bf16_t* outp = ST + (size_t)(seq * 64 + c) * C::PP * 128;
#pragma unroll
            for (int nt = 0; nt < 8; ++nt) { f32x4 acc = {0.f, 0.f, 0.f, 0.f}; bf16x8 af[4]; tr_frags4<136>(af, sBm, nt * 16);
#pragma unroll
                for (int ks = 0; ks < 4; ++ks) acc = mfma16(af[ks], bfr[ks], acc);
                u32x2 o; o.x = pk2(acc[0], acc[1]); o.y = pk2(acc[2], acc[3]);
                *(u32x2*)(outp + (pt * 16 + lr) * 128 + nt * 16 + 4 * lq) = o; }
        }
        if (tid < 2 * C::NH) { const int hl = tid >> 1, dir = tid & 1, headg = (MODE == 0) ? g * 4 + hl : g; atot[((b * C::NHT + headg) * 2 + dir) * 64 + c] = sTot[tid]; }
        __syncthreads();
    }
}
template <int MODE>
__device__ __forceinline__ void ssd_m2(KPR p) {
    typedef SsdCfg<MODE> C;
    bf16_t* ST = (bf16_t*)(p.ws + WS_AUX); const float* atot = (const float*)(p.ws + WS_ATOT);
    constexpr int PER = C::PP * 128 / 4, NSEQ = 4 * C::NHT * 2, TOTAL = NSEQ * PER;
    for (int task = blockIdx.x * 512 + ltid(); task < TOTAL; task += gridDim.x * 512) {
        const int seq = task / PER, off = (task % PER) * 4, dir = seq & 1;
        float h0 = 0.f, h1 = 0.f, h2 = 0.f, h3 = 0.f;
#pragma unroll 1
        for (int cb = 0; cb < 64; cb += 16) {
            u32x2 sv[16]; float dv[16];
#pragma unroll
            for (int i = 0; i < 16; ++i) { const int c = dir ? 63 - (cb + i) : (cb + i); sv[i] = *(const u32x2*)(ST + (size_t)(seq * 64 + c) * C::PP * 128 + off); dv[i] = atot[seq * 64 + c]; }
#pragma unroll
            for (int i = 0; i < 16; ++i) { const int c = dir ? 63 - (cb + i) : (cb + i); const float d = __expf(dv[i]);
                u32x2 o; o.x = pk2(h0, h1); o.y = pk2(h2, h3); *(u32x2*)(ST + (size_t)(seq * 64 + c) * C::PP * 128 + off) = o;
                h0 = h0 * d + __uint_as_float(sv[i].x << 16); h1 = h1 * d + __uint_as_float(sv[i].x & 0xffff0000u);
                h2 = h2 * d + __uint_as_float(sv[i].y << 16); h3 = h3 * d + __uint_as_float(sv[i].y & 0xffff0000u); }
        }
    }
}
template <int MODE>
__device__ __forceinline__ void ssd_m3(KPR p, int layer, unsigned char* smem) {
    typedef SsdCfg<MODE> C;
    constexpr int XS = (MODE == 0) ? 72 : 152;
    bf16_t* sC = (bf16_t*)smem; bf16_t* sB = (bf16_t*)(smem + 34816); bf16_t* sXT = (bf16_t*)(smem + 73984); bf16_t* sG = (bf16_t*)(smem + 113152);
    float* sE = (float*)(smem + 147968); float* sWv = sE + 1024;
    const bf16_t* proj = (const bf16_t*)(p.ws + WS_PROJ); const bf16_t* ST = (const bf16_t*)(p.ws + WS_AUX); bf16_t* Y = (bf16_t*)(p.ws + WS_Y);
    const int tid = ltid(), wid = tid >> 6, lane = tid & 63, lr = lane & 15, lq = lane >> 4;
    const float* cw = p.in[MODE == 0 ? I_MBCW : I_MLCW] + layer * 3 * 1024; const float* cb = p.in[MODE == 0 ? I_MBCB : I_MLCB] + layer * 1024;
    for (int it = blockIdx.x; it < C::NITEM; it += gridDim.x) {
        int g, c, b;
        if (MODE == 0) { g = it & 1; c = (it >> 1) & 63; b = it >> 7; } else { g = it & 3; c = (it >> 2) & 63; b = it >> 8; }
        const int tok0 = b * SEQ + c * 128, tpos0 = c * 128;
        if (MODE == 0) {
            load_chunk<true, 128>(sC, 136, proj, C::LD, tok0, tpos0, 768 + g * 128, cw, cb, 1024, 768 + g * 128, 1.0f);
            load_chunk<true, 128>(sB, 136, proj, C::LD, tok0, tpos0, 512 + g * 128, cw, cb, 1024, 512 + g * 128, 1.0f);
        } else {
            load_chunk<true, 128>(sC, 136, proj, C::LD, tok0, tpos0, g * 128, cw, cb, 1024, g * 128, 1.0f);
            load_chunk<true, 128>(sB, 136, proj, C::LD, tok0, tpos0, 512 + g * 128, cw, cb, 1024, 512 + g * 128, 0.08838834764831845f);
        }
        if (MODE == 1) { load_chunk<false, 128>(sG, 136, proj, C::LD, tok0, tpos0, 1024 + g * 128, cw, cb, 1024, 0, 1.0f);
            for (int idx = tid; idx < 16 * 128; idx += 512) sXT[(128 + (idx >> 7)) * 136 + (idx & 127)] = (idx < 128) ? (bf16_t)0x3F80 : (bf16_t)0; }
        if (wid < 2 * C::NH) { const int hl = wid >> 1, dir = wid & 1, headg = (MODE == 0) ? g * 4 + hl : g; decay_prep<MODE>(p, layer, wid, headg, dir, tok0, sE, sWv, nullptr, nullptr); }
        __syncthreads();
        if (MODE == 1) lds_transpose(sG, 136, sXT, 128);
        f32x4 accG[8];
#pragma unroll
        for (int st = 0; st < 8; ++st) { accG[st] = (f32x4){0.f, 0.f, 0.f, 0.f};
#pragma unroll
            for (int ks = 0; ks < 4; ++ks) accG[st] = mfma16(*(const bf16x8*)(sC + (16 * wid + lr) * 136 + ks * 32 + 8 * lq), *(const bf16x8*)(sB + (st * 16 + lr) * 136 + ks * 32 + 8 * lq), accG[st]); }
        __syncthreads();
        f32x4 outv[C::PTO]; float ssr[4] = {0.f, 0.f, 0.f, 0.f};
#pragma unroll 1
        for (int hl = 0; hl < C::NH; ++hl) {
            const int headg = (MODE == 0) ? g * 4 + hl : g;
#pragma unroll
            for (int i = 0; i < C::PTO; ++i) outv[i] = (f32x4){0.f, 0.f, 0.f, 0.f};
            if (MODE == 0) { load_chunk<true, 64>(sG, 72, proj, C::LD, tok0, tpos0, headg * 64, cw, cb, 1024, headg * 64, 1.0f); __syncthreads(); lds_transpose(sG, 72, sXT, 64); __syncthreads(); }

#pragma unroll 1
            for (int dir = 0; dir < 2; ++dir) {
                const int hdl = hl * 2 + dir, seq = (b * C::NHT + headg) * 2 + dir;
                const bf16_t* Hs = ST + (size_t)(seq * 64 + c) * C::PP * 128;
                { constexpr int NHT_T = (C::PP * 16 + 511) / 512; u32x4 hv[NHT_T];
#pragma unroll
                  for (int i = 0; i < NHT_T; ++i) { const int task = tid + 512 * i, tk = task < C::PP * 16 ? task : 0; hv[i] = *(const u32x4*)(Hs + (tk >> 4) * 128 + (tk & 15) * 8); }
#pragma unroll
                  for (int i = 0; i < NHT_T; ++i) { const int task = tid + 512 * i; if (task < C::PP * 16) *(u32x4*)(sB + (task >> 4) * 136 + (task & 15) * 8) = hv[i]; } }
                float et[4];
#pragma unroll
                for (int j = 0; j < 4; ++j) et[j] = sE[hdl * 128 + 16 * wid + 4 * lq + j];
#pragma unroll
                for (int st = 0; st < 8; ++st) { const int s = st * 16 + lr; const float es = sE[hdl * 128 + s], ws = sWv[hdl * 128 + s];
#pragma unroll
                    for (int j = 0; j < 4; ++j) { const int t = 16 * wid + 4 * lq + j; const bool valid = dir ? (s >= t) : (s <= t);
                        const float val = valid ? accG[st][j] * __expf(fminf(et[j] - es, 0.f)) * ws : 0.f; sG[t * 136 + s] = f2bf(val); } }
                __syncthreads();
                f32x4 acc[C::PT];
#pragma unroll
                for (int pt = 0; pt < C::PT; ++pt) acc[pt] = (f32x4){0.f, 0.f, 0.f, 0.f};
#pragma unroll
                for (int ks = 0; ks < 4; ++ks) { const bf16x8 a2 = *(const bf16x8*)(sC + (16 * wid + lr) * 136 + ks * 32 + 8 * lq);
#pragma unroll
                    for (int pt = 0; pt < C::PT; ++pt) acc[pt] = mfma16(a2, *(const bf16x8*)(sB + (pt * 16 + lr) * 136 + ks * 32 + 8 * lq), acc[pt]); }
#pragma unroll
                for (int j = 0; j < 4; ++j) { const float ex = __expf(et[j]);
#pragma unroll
                    for (int pt = 0; pt < C::PT; ++pt) acc[pt][j] *= ex; }
#pragma unroll
                for (int ks = 0; ks < 4; ++ks) { const bf16x8 a = *(const bf16x8*)(sG + (16 * wid + lr) * 136 + ks * 32 + 8 * lq);
#pragma unroll
                    for (int pt = 0; pt < C::PT; ++pt) acc[pt] = mfma16(a, *(const bf16x8*)(sXT + (pt * 16 + lr) * 136 + ks * 32 + 8 * lq), acc[pt]); }
#pragma unroll
                for (int j = 0; j < 4; ++j) {
                    if (MODE == 0) {
#pragma unroll
                        for (int pt = 0; pt < 4; ++pt) outv[pt][j] += acc[pt][j];
                    } else {
                        float den = acc[C::PT - 1][j]; den = __shfl(den, lane & 48); const float inv = rcp_f(fmaxf(fabsf(den), 1.0f));
#pragma unroll
                        for (int pt = 0; pt < 8; ++pt) outv[pt][j] += acc[pt][j] * inv;
                    } }
                __syncthreads();
            }
            if (MODE == 0) { const float D = p.in[I_MBD][layer * 8 + headg];
#pragma unroll
                for (int pt = 0; pt < 4; ++pt)
#pragma unroll
                    for (int j = 0; j < 4; ++j) outv[pt][j] += D * bf2f(sXT[(pt * 16 + lr) * 136 + 16 * wid + 4 * lq + j]);
#pragma unroll
                for (int j = 0; j < 4; ++j) { const size_t tok = (size_t)tok0 + 16 * wid + 4 * lq + j;
#pragma unroll
                    for (int pt = 0; pt < 4; ++pt) { const int col = hl * 64 + pt * 16 + lr; const float z = bf2f(proj[tok * 1536 + 1024 + g * 256 + col]); const float v = outv[pt][j] * silu_f(z);
                        ssr[j] += v * v; Y[tok * 2048 + 512 + g * 256 + col] = f2bf(v); } }
                __syncthreads(); }
        }
        if (MODE == 0) {
            float* sR = sE;
#pragma unroll
            for (int j = 0; j < 4; ++j) { float ss = ssr[j];
#pragma unroll
                for (int d = 1; d < 16; d <<= 1) ss += __shfl_xor(ss, d);
                if (lr == 0) sR[16 * wid + 4 * lq + j] = rsqrtf(ss * (1.0f / 256.0f) + 1e-6f); }
            __syncthreads();
            for (int task = tid; task < 128 * 32; task += 512) { const int r = task >> 5, cgp = task & 31; bf16_t* yp = Y + ((size_t)tok0 + r) * 2048 + 512 + g * 256 + cgp * 8;
                float v[8]; unpack8(*(const u32x4*)yp, v); const float rstd = sR[r]; const float* nw = p.in[I_MBNW] + layer * 512 + g * 256 + cgp * 8;
#pragma unroll
                for (int e = 0; e < 8; ++e) v[e] *= rstd * nw[e];
                *(u32x4*)yp = pack8(v); }
        } else {
            float* sH = (float*)smem;
#pragma unroll
            for (int i = 0; i < 8; ++i)
#pragma unroll
                for (int j = 0; j < 4; ++j) sH[(16 * wid + 4 * lq + j) * 132 + i * 16 + lr] = outv[i][j];
            asm volatile("s_waitcnt lgkmcnt(0)" ::: "memory");
            { u32x4 ou[4], zu[4];
#pragma unroll
              for (int i = 0; i < 4; ++i) { const int task = lane + 64 * i, row = 16 * wid + (task >> 4), cgp = task & 15; const bf16_t* pp = proj + ((size_t)tok0 + row) * 2560 + 1536 + g * 128 + cgp * 8;
                  ou[i] = *(const u32x4*)pp; zu[i] = *(const u32x4*)(pp + 512); }
              const f32x4 nw0 = *(const f32x4*)(p.in[I_MLNW] + layer * 512 + g * 128 + (lane & 15) * 8), nw1 = *(const f32x4*)(p.in[I_MLNW] + layer * 512 + g * 128 + (lane & 15) * 8 + 4);
#pragma unroll
              for (int i = 0; i < 4; ++i) { const int task = lane + 64 * i, row = 16 * wid + (task >> 4), cgp = task & 15; float o[8], z[8], v[8]; unpack8(ou[i], o); unpack8(zu[i], z);
                  const f32x4 h0 = *(const f32x4*)(sH + row * 132 + cgp * 8), h1 = *(const f32x4*)(sH + row * 132 + cgp * 8 + 4); float ss = 0.f;
#pragma unroll
                  for (int e = 0; e < 8; ++e) { v[e] = (e < 4 ? h0[e] : h1[e - 4]) * sigmoid_f(o[e]); ss += v[e] * v[e]; }
#pragma unroll
                  for (int d = 1; d < 16; d <<= 1) ss += __shfl_xor(ss, d);
                  const float rstd = rsqrtf(ss * (1.0f / 128.0f) + 1e-6f);
#pragma unroll
                  for (int e = 0; e < 8; ++e) v[e] *= rstd * (e < 4 ? nw0[e] : nw1[e - 4]) * silu_f(z[e]);
                  *(u32x4*)(Y + ((size_t)tok0 + row) * 2048 + 1024 + g * 128 + cgp * 8) = pack8(v); } }
        }
        __syncthreads();
    }
}
__device__ __forceinline__ void ssd_m3_mamba(KPR p, int layer, unsigned char* smem) {
    bf16_t* sC = (bf16_t*)smem; bf16_t* sB = (bf16_t*)(smem + 34816); bf16_t* sXT = (bf16_t*)(smem + 73984); bf16_t* sG = (bf16_t*)(smem + 113152);
    float* sE = (float*)(smem + 147968); float* sWv = sE + 1024;
    const bf16_t* proj = (const bf16_t*)(p.ws + WS_PROJ); const bf16_t* ST = (const bf16_t*)(p.ws + WS_AUX); bf16_t* Y = (bf16_t*)(p.ws + WS_Y);
    const int tid = ltid(), wid = tid >> 6, lane = tid & 63, lr = lane & 15, lq = lane >> 4;
    const float* cw = p.in[I_MBCW] + layer * 3 * 1024; const float* cb = p.in[I_MBCB] + layer * 1024;
    for (int it = blockIdx.x; it < 512; it += gridDim.x) {
        const int g = it & 1, c = (it >> 1) & 63, b = it >> 7, tok0 = b * SEQ + c * 128, tpos0 = c * 128;
        load_chunk<true, 128>(sC, 136, proj, 1536, tok0, tpos0, 768 + g * 128, cw, cb, 1024, 768 + g * 128, 1.0f);
        load_chunk<true, 128>(sB, 136, proj, 1536, tok0, tpos0, 512 + g * 128, cw, cb, 1024, 512 + g * 128, 1.0f);
        { const int hl = wid >> 1, dir = wid & 1; decay_prep<0>(p, layer, wid, g * 4 + hl, dir, tok0, sE, sWv, nullptr, nullptr); }
        __syncthreads();
        f32x4 accG[8];
#pragma unroll
        for (int st = 0; st < 8; ++st) { accG[st] = (f32x4){0.f, 0.f, 0.f, 0.f};
#pragma unroll
            for (int ks = 0; ks < 4; ++ks) accG[st] = mfma16(*(const bf16x8*)(sC + (16 * wid + lr) * 136 + ks * 32 + 8 * lq), *(const bf16x8*)(sB + (st * 16 + lr) * 136 + ks * 32 + 8 * lq), accG[st]); }
        __syncthreads();
        float ssr[4] = {0.f, 0.f, 0.f, 0.f};
#pragma unroll 1
        for (int hl = 0; hl < 4; ++hl) {
            const int headg = g * 4 + hl;
            load_chunk<true, 64>(sG, 72, proj, 1536, tok0, tpos0, headg * 64, cw, cb, 1024, headg * 64, 1.0f);
            { const bf16_t* Hf = ST + (size_t)(((b * 8 + headg) * 2) * 64 + c) * 8192; const bf16_t* Hb = ST + (size_t)(((b * 8 + headg) * 2 + 1) * 64 + c) * 8192;
              u32x4 hv[4];
#pragma unroll
              for (int i = 0; i < 4; ++i) { const int task = tid + 512 * i, row = task >> 4, cgp = task & 15; const bf16_t* src = (row < 64) ? (Hf + row * 128) : (Hb + (row - 64) * 128); hv[i] = *(const u32x4*)(src + cgp * 8); }
              load_chunk<true, 64>(sXT, 72, proj, 1536, tok0, tpos0, headg * 64, cw, cb, 1024, headg * 64, 1.0f);
#pragma unroll
              for (int i = 0; i < 4; ++i) { const int task = tid + 512 * i; *(u32x4*)(sB + (task >> 4) * 136 + (task & 15) * 8) = hv[i]; } }
            float etf[4], etb[4];
#pragma unroll
            for (int j = 0; j < 4; ++j) { etf[j] = sE[(hl * 2) * 128 + 16 * wid + 4 * lq + j]; etb[j] = sE[(hl * 2 + 1) * 128 + 16 * wid + 4 * lq + j]; }
#pragma unroll
            for (int st = 0; st < 8; ++st) { const int s = st * 16 + lr; const float esf = sE[(hl * 2) * 128 + s], wsf = sWv[(hl * 2) * 128 + s], esb = sE[(hl * 2 + 1) * 128 + s], wsb = sWv[(hl * 2 + 1) * 128 + s];
#pragma unroll
                for (int j = 0; j < 4; ++j) { const int t = 16 * wid + 4 * lq + j;
                    const float df = (s <= t) ? __expf(fminf(etf[j] - esf, 0.f)) * wsf : 0.f, db = (s >= t) ? __expf(fminf(etb[j] - esb, 0.f)) * wsb : 0.f;
                    sG[t * 136 + s] = f2bf(accG[st][j] * (df + db)); } }
            __syncthreads();
            f32x4 accd[4], accf[4], accb[4];
#pragma unroll
            for (int pt = 0; pt < 4; ++pt) { accd[pt] = (f32x4){0.f, 0.f, 0.f, 0.f}; accf[pt] = accd[pt]; accb[pt] = accd[pt]; }
            { bf16x8 ag[4], ac[4];
#pragma unroll
              for (int ks = 0; ks < 4; ++ks) { ag[ks] = *(const bf16x8*)(sG + (16 * wid + lr) * 136 + ks * 32 + 8 * lq); ac[ks] = *(const bf16x8*)(sC + (16 * wid + lr) * 136 + ks * 32 + 8 * lq); }
#pragma unroll
              for (int pt = 0; pt < 4; ++pt) { bf16x8 xb[4]; tr_frags4<72>(xb, sXT, pt * 16);
#pragma unroll
                  for (int ks = 0; ks < 4; ++ks) { accd[pt] = mfma16(ag[ks], xb[ks], accd[pt]);
                      accf[pt] = mfma16(ac[ks], *(const bf16x8*)(sB + (pt * 16 + lr) * 136 + ks * 32 + 8 * lq), accf[pt]);
                      accb[pt] = mfma16(ac[ks], *(const bf16x8*)(sB + (64 + pt * 16 + lr) * 136 + ks * 32 + 8 * lq), accb[pt]); } } }
            const float D = p.in[I_MBD][layer * 8 + headg];
            bf16_t zraw[4][4];
#pragma unroll
            for (int pt = 0; pt < 4; ++pt)
#pragma unroll
                for (int j = 0; j < 4; ++j) zraw[pt][j] = proj[((size_t)tok0 + 16 * wid + 4 * lq + j) * 1536 + 1024 + g * 256 + hl * 64 + pt * 16 + lr];
#pragma unroll
            for (int pt = 0; pt < 4; ++pt) { float xv[4];
#pragma unroll
                for (int j = 0; j < 4; ++j) xv[j] = bf2f(sXT[(16 * wid + 4 * lq + j) * 72 + pt * 16 + lr]);
#pragma unroll
                for (int j = 0; j < 4; ++j) { const size_t tok = (size_t)tok0 + 16 * wid + 4 * lq + j; const int col = hl * 64 + pt * 16 + lr;
                    const float yv = accd[pt][j] + __expf(etf[j]) * accf[pt][j] + __expf(etb[j]) * accb[pt][j] + D * xv[j];
                    const float z = bf2f(zraw[pt][j]); const float v = yv * silu_f(z);
                    ssr[j] += v * v; Y[tok * 2048 + 512 + g * 256 + col] = f2bf(v); } }
            __syncthreads();
        }
        float* sR = sE;
#pragma unroll
        for (int j = 0; j < 4; ++j) { float ss = ssr[j];
#pragma unroll
            for (int d = 1; d < 16; d <<= 1) ss += __shfl_xor(ss, d);
            if (lr == 0) sR[16 * wid + 4 * lq + j] = rsqrtf(ss * (1.0f / 256.0f) + 1e-6f); }
        __syncthreads();
#pragma unroll 1
        for (int bt = 0; bt < 2; ++bt) { u32x4 yv[4];
#pragma unroll
            for (int i = 0; i < 4; ++i) { const int task = tid + 512 * (bt * 4 + i), r = task >> 5, cgp = task & 31; yv[i] = *(const u32x4*)(Y + ((size_t)tok0 + r) * 2048 + 512 + g * 256 + cgp * 8); }
#pragma unroll
            for (int i = 0; i < 4; ++i) { const int task = tid + 512 * (bt * 4 + i), r = task >> 5, cgp = task & 31; float v[8]; unpack8(yv[i], v); const float rstd = sR[r]; const float* nw = p.in[I_MBNW] + layer * 512 + g * 256 + cgp * 8;
#pragma unroll
                for (int e = 0; e < 8; ++e) v[e] *= rstd * nw[e];
                *(u32x4*)(Y + ((size_t)tok0 + r) * 2048 + 512 + g * 256 + cgp * 8) = pack8(v); } }
        __syncthreads();
    }
}
__device__ __forceinline__ void na_phase(KPR p, int layer, unsigned char* smem) {
    bf16_t* sV = (bf16_t*)smem;
    bf16_t* sP = (bf16_t*)(smem + 82944);
    float* sRpb = (float*)(smem + 82944 + 67584);
    const bf16_t* proj = (const bf16_t*)(p.ws + WS_PROJ); bf16_t* Y = (bf16_t*)(p.ws + WS_Y);
    const float* qnw = p.in[I_NAQN] + layer * 64; const float* knw = p.in[I_NAKN] + layer * 64; const float* rpb = p.in[I_NARPB] + layer * 8 * 15 * 31;
    const int tid = ltid(), wid = tid >> 6, lane = tid & 63, lr = lane & 15, lq = lane >> 4;
    bf16_t* sPw = sP + wid * 16 * 264;
    for (int it = blockIdx.x; it < 2048; it += gridDim.x) {
        const int h = it & 7, rp = (it >> 3) & 63, b = it >> 9, r0 = 2 * rp, base = clampi(r0 - 4, 0, 120);
        const int r = r0 + (wid >> 2), qt = wid & 3, rs = clampi(r - 4, 0, 120), cbase = clampi(16 * qt - 8, 0, 32);
        u32x4 ka0[4], ka1[4], uq0, uq1;
        auto load_kgroup = [&](u32x4 (&k0)[4], u32x4 (&k1)[4], int kg) {
#pragma unroll
            for (int kk = 0; kk < 4; ++kk) { const int kt = kg * 4 + kk, i = kt >> 1, cc0 = (kt & 1) * 16, kc = cbase + cc0 + lr, kr = rs + i;
                const bf16_t* kp = proj + (size_t)(b * SEQ + kr * 64 + kc) * 2048 + 512 + h * 64 + 8 * lq; k0[kk] = *(const u32x4*)kp; k1[kk] = *(const u32x4*)(kp + 32); } };
        { u32x4 vv[9];
#pragma unroll
          for (int i = 0; i < 9; ++i) { const int task = tid + 512 * i, kk = task >> 3, dg = task & 7; int row = base + (kk >> 6); row = row < 128 ? row : 127;
              vv[i] = *(const u32x4*)(proj + (size_t)(b * SEQ + row * 64 + (kk & 63)) * 2048 + 1024 + h * 64 + dg * 8); }
          { const bf16_t* qp = proj + (size_t)(b * SEQ + r * 64 + 16 * qt + lr) * 2048 + h * 64 + 8 * lq; uq0 = *(const u32x4*)qp; uq1 = *(const u32x4*)(qp + 32); }
          load_kgroup(ka0, ka1, 0);
#pragma unroll
          for (int i = 0; i < 9; ++i) { const int task = tid + 512 * i, kk = task >> 3, dg = task & 7; *(u32x4*)(sV + kk * 72 + dg * 8) = vv[i]; } }
        if (tid < 465) sRpb[tid] = rpb[h * 465 + tid];
        __syncthreads();
        u32x4 kb0[4], kb1[4]; load_kgroup(kb0, kb1, 1);
        bf16x8 qf[2];
        { float v0[8], v1[8]; unpack8(uq0, v0); unpack8(uq1, v1);
          float ss = 0.f;
#pragma unroll
          for (int e = 0; e < 8; ++e) ss += v0[e] * v0[e] + v1[e] * v1[e];
          ss += __shfl_xor(ss, 16); ss += __shfl_xor(ss, 32); const float rstd = rsqrtf(ss * (1.0f / 64.0f) + 1e-6f) * 0.125f;
#pragma unroll
          for (int e = 0; e < 8; ++e) { v0[e] *= rstd * qnw[8 * lq + e] * knw[8 * lq + e]; v1[e] *= rstd * qnw[32 + 8 * lq + e] * knw[32 + 8 * lq + e]; }
          qf[0] = as_bf16x8(pack8(v0)); qf[1] = as_bf16x8(pack8(v1)); }
        f32x4 S[16];
        bool vld[2][4]; int bof[2][4];
#pragma unroll
        for (int par = 0; par < 2; ++par)
#pragma unroll
            for (int j = 0; j < 4; ++j) { const int cq = 16 * qt + 4 * lq + j, st = clampi(cq - 8, 0, 48), kc = cbase + par * 16 + lr; vld[par][j] = (kc >= st) && (kc < st + 16);
                bof[par][j] = vld[par][j] ? (rs - r + 7) * 31 + (kc - cq + 15) : 0; }
        auto score_kgroup = [&](const u32x4 (&k0)[4], const u32x4 (&k1)[4], int kg) {
#pragma unroll
            for (int kk = 0; kk < 4; ++kk) { const int kt = kg * 4 + kk, i = kt >> 1, par = kt & 1;
                float v0[8], v1[8]; unpack8(k0[kk], v0); unpack8(k1[kk], v1); float ss = 0.f;
#pragma unroll
                for (int e = 0; e < 8; ++e) ss += v0[e] * v0[e] + v1[e] * v1[e];
                ss += __shfl_xor(ss, 16); ss += __shfl_xor(ss, 32); const float rstd = rsqrtf(ss * (1.0f / 64.0f) + 1e-6f);
                f32x4 acc = {0.f, 0.f, 0.f, 0.f}; acc = mfma16(qf[0], as_bf16x8(k0[kk]), acc); acc = mfma16(qf[1], as_bf16x8(k1[kk]), acc);
#pragma unroll
                for (int j = 0; j < 4; ++j) S[kt][j] = vld[par][j] ? acc[j] * rstd + sRpb[bof[par][j] + 31 * i] : -1e30f; } };
        score_kgroup(ka0, ka1, 0); load_kgroup(ka0, ka1, 2);
        score_kgroup(kb0, kb1, 1); load_kgroup(kb0, kb1, 3);
        score_kgroup(ka0, ka1, 2);
        score_kgroup(kb0, kb1, 3);
        float inv[4];
#pragma unroll
        for (int j = 0; j < 4; ++j) { float m = S[0][j];
#pragma unroll
            for (int kt = 1; kt < 16; ++kt) m = fmaxf(m, S[kt][j]);
#pragma unroll
            for (int d = 1; d < 16; d <<= 1) m = fmaxf(m, __shfl_xor(m, d));
            float sum = 0.f;
#pragma unroll
            for (int kt = 0; kt < 16; ++kt) { const float e = __expf(S[kt][j] - m); S[kt][j] = e; sum += e; }
#pragma unroll
            for (int d = 1; d < 16; d <<= 1) sum += __shfl_xor(sum, d);
            inv[j] = rcp_f(sum); }
#pragma unroll
        for (int kt = 0; kt < 16; ++kt)
#pragma unroll
            for (int j = 0; j < 4; ++j) sPw[(4 * lq + j) * 264 + kt * 16 + lr] = f2bf(S[kt][j]);
        asm volatile("s_waitcnt lgkmcnt(0)" ::: "memory");
        f32x4 O[4];
#pragma unroll
        for (int dt = 0; dt < 4; ++dt) O[dt] = (f32x4){0.f, 0.f, 0.f, 0.f};
#pragma unroll
        for (int ks = 0; ks < 8; ++ks) { const bf16x8 a = *(const bf16x8*)(sPw + lr * 264 + ks * 32 + 8 * lq); const int vkey = (rs - base + ks) * 64 + cbase + 8 * lq;
#pragma unroll
            for (int dt = 0; dt < 4; ++dt) O[dt] = mfma16(a, gather8(sV + vkey * 72 + dt * 16 + lr, 72), O[dt]); }
        asm volatile("s_waitcnt lgkmcnt(0)" ::: "memory");
        { float* sO = (float*)sPw;
#pragma unroll
          for (int dt = 0; dt < 4; ++dt)
#pragma unroll
              for (int j = 0; j < 4; ++j) sO[(4 * lq + j) * 68 + dt * 16 + lr] = O[dt][j] * inv[j];
          asm volatile("s_waitcnt lgkmcnt(0)" ::: "memory");
          u32x4 gu[2];
#pragma unroll
          for (int i = 0; i < 2; ++i) { const int task = lane + 64 * i, q = task >> 3, cgp = task & 7; gu[i] = *(const u32x4*)(proj + ((size_t)b * SEQ + r * 64 + 16 * qt + q) * 2048 + 1536 + h * 64 + cgp * 8); }
#pragma unroll
          for (int i = 0; i < 2; ++i) { const int task = lane + 64 * i, q = task >> 3, cgp = task & 7; float gv[8], v[8]; unpack8(gu[i], gv);
              const f32x4 o0 = *(const f32x4*)(sO + q * 68 + cgp * 8), o1 = *(const f32x4*)(sO + q * 68 + cgp * 8 + 4);
#pragma unroll
              for (int e = 0; e < 8; ++e) v[e] = (e < 4 ? o0[e] : o1[e - 4]) * silu_f(gv[e]);
              *(u32x4*)(Y + ((size_t)b * SEQ + r * 64 + 16 * qt + q) * 2048 + 1536 + h * 64 + cgp * 8) = pack8(v); } }
        __syncthreads();
    }
}

__device__ __forceinline__ void hy_prep(KPR p, int layer, unsigned char* smem) {
    bf16_t* tile = (bf16_t*)smem;
    const bf16_t* proj = (const bf16_t*)(p.ws + WS_PROJ); bf16_t* hyT = (bf16_t*)(p.ws + WS_AUX);
    const float* cw = p.in[I_HYCW] + layer * 3 * 1536; const float* cb = p.in[I_HYCB] + layer * 1536;
    const int tid = ltid();
    for (int it = blockIdx.x; it < 24 * 64; it += gridDim.x) {
        const int ct = it % 24, tt = it / 24, b = tt >> 4, t0 = (tt & 15) * 512, c0 = ct * 64, cgp = tid & 7;
        float wv[4][8];
#pragma unroll
        for (int e = 0; e < 8; ++e) { wv[0][e] = cw[c0 + cgp * 8 + e]; wv[1][e] = cw[1536 + c0 + cgp * 8 + e]; wv[2][e] = cw[3072 + c0 + cgp * 8 + e]; wv[3][e] = cb[c0 + cgp * 8 + e]; }
#pragma unroll 1
        for (int half = 0; half < 2; ++half) {
            u32x4 u0[4], u1[4], u2[4];
#pragma unroll
            for (int i = 0; i < 4; ++i) { const int r = (tid >> 3) + 64 * (half * 4 + i), tpos = t0 + r;
                const bf16_t* pp = proj + (size_t)(b * SEQ + tpos) * 2048 + c0 + cgp * 8;
                u1[i] = *(const u32x4*)pp; u0[i] = (u32x4){0u, 0u, 0u, 0u}; u2[i] = (u32x4){0u, 0u, 0u, 0u};
                if (tpos > 0) u0[i] = *(const u32x4*)(pp - 2048);
                if (tpos < SEQ - 1) u2[i] = *(const u32x4*)(pp + 2048); }
#pragma unroll
            for (int i = 0; i < 4; ++i) { const int r = (tid >> 3) + 64 * (half * 4 + i); float x0[8], x1[8], x2[8], v[8]; unpack8(u0[i], x0); unpack8(u1[i], x1); unpack8(u2[i], x2);
#pragma unroll
                for (int e = 0; e < 8; ++e) v[e] = wv[3][e] + wv[0][e] * x0[e] + wv[1][e] * x1[e] + wv[2][e] * x2[e];
                *(u32x4*)(tile + r * 72 + cgp * 8) = pack8(v); }
        }
        __syncthreads();
        bf16_t* tileT = tile + 512 * 72;
#pragma unroll
        for (int i = 0; i < 8; ++i) { const int task = tid + 512 * i, c = task & 63, tg = task >> 6; const bf16_t* sp = tile + (tg * 8) * 72 + c; u32x4 w;
            w.x = (unsigned)sp[0] | ((unsigned)sp[72] << 16); w.y = (unsigned)sp[144] | ((unsigned)sp[216] << 16); w.z = (unsigned)sp[288] | ((unsigned)sp[360] << 16); w.w = (unsigned)sp[432] | ((unsigned)sp[504] << 16);
            *(u32x4*)(tileT + c * 520 + tg * 8) = w; }
        __syncthreads();
#pragma unroll
        for (int i = 0; i < 8; ++i) { const int task = tid + 512 * i, c = task >> 6, tg = task & 63;
            *(u32x4*)(hyT + ((size_t)(c0 + c) * 4 + b) * SEQ + t0 + tg * 8) = *(const u32x4*)(tileT + c * 520 + tg * 8); }
    }
}
__device__ __forceinline__ void hy_post(KPR p, unsigned char* smem) {
    bf16_t* tile = (bf16_t*)smem;
    bf16_t* tileT = tile + 64 * 520;
    const bf16_t* proj = (const bf16_t*)(p.ws + WS_PROJ); const bf16_t* hyT = (const bf16_t*)(p.ws + WS_AUX); bf16_t* Y = (bf16_t*)(p.ws + WS_Y);
    const int tid = ltid();
    for (int it = blockIdx.x; it < 8 * 64; it += gridDim.x) {
        const int ct = it & 7, tt = it >> 3, b = tt >> 4, t0 = (tt & 15) * 512;
        { u32x4 tv[8];
#pragma unroll
          for (int i = 0; i < 8; ++i) { const int task = tid + 512 * i, c = task >> 6, tg = task & 63; tv[i] = *(const u32x4*)(hyT + ((size_t)(ct * 64 + c) * 4 + b) * SEQ + t0 + tg * 8); }
#pragma unroll
          for (int i = 0; i < 8; ++i) { const int task = tid + 512 * i, c = task >> 6, tg = task & 63; *(u32x4*)(tile + c * 520 + tg * 8) = tv[i]; } }
        __syncthreads();
#pragma unroll
        for (int i = 0; i < 8; ++i) { const int task = tid + 512 * i, t = task & 511, cgp = task >> 9; const bf16_t* sp = tile + (cgp * 8) * 520 + t; u32x4 w;
            w.x = (unsigned)sp[0] | ((unsigned)sp[520] << 16); w.y = (unsigned)sp[1040] | ((unsigned)sp[1560] << 16); w.z = (unsigned)sp[2080] | ((unsigned)sp[2600] << 16); w.w = (unsigned)sp[3120] | ((unsigned)sp[3640] << 16);
            *(u32x4*)(tileT + t * 72 + cgp * 8) = w; }
        __syncthreads();
        { u32x4 gu[8];
#pragma unroll
          for (int i = 0; i < 8; ++i) { const int task = tid + 512 * i, r = task >> 3, cgp = task & 7; gu[i] = *(const u32x4*)(proj + ((size_t)b * SEQ + t0 + r) * 2048 + 1536 + ct * 64 + cgp * 8); }
#pragma unroll
          for (int i = 0; i < 8; ++i) { const int task = tid + 512 * i, r = task >> 3, cgp = task & 7; float gv[8], v[8]; unpack8(gu[i], gv); unpack8(*(const u32x4*)(tileT + r * 72 + cgp * 8), v);
#pragma unroll
              for (int e = 0; e < 8; ++e) v[e] *= silu_f(gv[e]);
              *(u32x4*)(Y + ((size_t)b * SEQ + t0 + r) * 2048 + ct * 64 + cgp * 8) = pack8(v); } }
    }
}
typedef float f32x2v __attribute__((ext_vector_type(2)));
__device__ __forceinline__ f32x2v cmul(f32x2v a, f32x2v b) {
    f32x2v t, r;
    asm("v_pk_mul_f32 %0, %1, %2 op_sel:[0,0] op_sel_hi:[0,1]" : "=&v"(t) : "v"(a), "v"(b));
    asm("v_pk_fma_f32 %0, %1, %2, %3 op_sel:[1,1,0] op_sel_hi:[1,0,1] neg_lo:[0,1,0]" : "=&v"(r) : "v"(a), "v"(b), "v"(t));
    return r;
}
__device__ __forceinline__ f32x2v cmulc(f32x2v a, f32x2v b) {
    f32x2v t, r;
    asm("v_pk_mul_f32 %0, %1, %2 op_sel:[0,0] op_sel_hi:[0,1] neg_hi:[0,1]" : "=&v"(t) : "v"(a), "v"(b));
    asm("v_pk_fma_f32 %0, %1, %2, %3 op_sel:[1,1,0] op_sel_hi:[1,0,1]" : "=&v"(r) : "v"(a), "v"(b), "v"(t));
    return r;
}
__device__ __forceinline__ constexpr float c16(int m) { return m == 0 ? 1.f : m == 1 ? 0.92387953251f : m == 2 ? 0.70710678119f : m == 3 ? 0.38268343237f : m == 4 ? 0.f : m == 5 ? -0.38268343237f : m == 6 ? -0.70710678119f : -0.92387953251f; }
__device__ __forceinline__ constexpr float s16(int m) { return m == 0 ? 0.f : m == 1 ? 0.38268343237f : m == 2 ? 0.70710678119f : m == 3 ? 0.92387953251f : m == 4 ? 1.f : m == 5 ? 0.92387953251f : m == 6 ? 0.70710678119f : 0.38268343237f; }
#define PIDX(i) ((i) + (((i) >> 6) << 2))
__device__ __forceinline__ constexpr int brev4(int i) { return ((i & 1) << 3) | ((i & 2) << 1) | ((i & 4) >> 1) | ((i & 8) >> 3); }
template <bool INV> __device__ __forceinline__ void r16_core(f32x2v (&x)[16], const f32x2v wa) {
    f32x2v w[16]; w[1] = wa; w[2] = cmul(wa, wa); w[3] = cmul(w[2], wa); w[4] = cmul(w[2], w[2]); w[5] = cmul(w[4], wa); w[6] = cmul(w[3], w[3]); w[7] = cmul(w[4], w[3]); w[8] = cmul(w[4], w[4]);
    w[9] = cmul(w[8], wa); w[10] = cmul(w[5], w[5]); w[11] = cmul(w[8], w[3]); w[12] = cmul(w[6], w[6]); w[13] = cmul(w[8], w[5]); w[14] = cmul(w[7], w[7]); w[15] = cmul(w[8], w[7]);
    if (!INV) {
#pragma unroll
        for (int h = 8; h >= 1; h >>= 1)
#pragma unroll
            for (int i = 0; i < 16; ++i) if ((i & h) == 0) { const int m = (i & (h - 1)) * (8 / h); const f32x2v a = x[i], b = x[i + h]; x[i] = a + b; const f32x2v d = a - b;
                x[i + h] = (m == 0) ? d : (m == 4) ? (f32x2v){d.y, -d.x} : cmul(d, (f32x2v){c16(m), -s16(m)}); }
#pragma unroll
        for (int i = 1; i < 16; ++i) x[i] = cmul(x[i], w[brev4(i)]);
    } else {
#pragma unroll
        for (int i = 1; i < 16; ++i) x[i] = cmulc(x[i], w[brev4(i)]);
#pragma unroll
        for (int h = 1; h <= 8; h <<= 1)
#pragma unroll
            for (int i = 0; i < 16; ++i) if ((i & h) == 0) { const int m = (i & (h - 1)) * (8 / h); const f32x2v b = x[i + h];
                const f32x2v t = (m == 0) ? b : (m == 4) ? (f32x2v){-b.y, b.x} : cmulc(b, (f32x2v){c16(m), -s16(m)}); const f32x2v a = x[i]; x[i] = a + t; x[i + h] = a - t; }
    }
}
template <int S, bool INV> __device__ __forceinline__ void r16_pass(f32x2v* buf) {
    const int tid = ltid();
#pragma unroll
    for (int r = 0; r < 2; ++r) { const int q = tid + 512 * r; int base; float f;
        if (S == 1024) { base = q; f = (float)q * (1.0f / 16384.0f); }
        else if (S == 64) { const int jj = q & 63; base = (q >> 6) * 1024 + jj; f = (float)jj * (1.0f / 1024.0f); }
        else { const int jj = q & 3; base = (q >> 2) * 64 + jj; f = (float)jj * (1.0f / 64.0f); }
        constexpr int PS = (S == 1024) ? 1088 : (S == 64) ? 68 : 4;
        f32x2v* bp = buf + PIDX(base); f32x2v x[16];
#pragma unroll
        for (int m = 0; m < 16; ++m) x[m] = bp[PS * m];
        f32x2v wa = {__builtin_amdgcn_cosf(f), -__builtin_amdgcn_sinf(f)};
        asm volatile("s_nop 1" : "+v"(wa));
        r16_core<INV>(x, wa);
#pragma unroll
        for (int m = 0; m < 16; ++m) bp[PS * m] = x[m]; }
    __syncthreads();
}
template <int MODE> __device__ __forceinline__ void r4_mid(f32x2v* buf, const f32x2v* G) {
    const int tid = ltid();
#pragma unroll 1
    for (int rb = 0; rb < 2; ++rb) {
        f32x4 g01[4], g23[4];
        if (MODE == 1) {
#pragma unroll
            for (int i = 0; i < 4; ++i) { const int q = tid + 512 * (rb * 4 + i); g01[i] = *(const f32x4*)(G + 4 * q); g23[i] = *(const f32x4*)(G + 4 * q + 2); } }
#pragma unroll
        for (int i = 0; i < 4; ++i) { const int q = tid + 512 * (rb * 4 + i); f32x2v* bp = buf + PIDX(4 * q);
            const f32x4 v01 = *(const f32x4*)bp, v23 = *(const f32x4*)(bp + 2);
            const f32x2v x0 = {v01[0], v01[1]}, x1 = {v01[2], v01[3]}, x2 = {v23[0], v23[1]}, x3 = {v23[2], v23[3]};
            const f32x2v a0 = x0 + x2, a2 = x0 - x2, a1 = x1 + x3, d = x1 - x3; const f32x2v a3 = {d.y, -d.x};
            f32x2v b0 = a0 + a1, b1 = a0 - a1, b2 = a2 + a3, b3 = a2 - a3;
            if (MODE == 1) {
                b0 = cmul(b0, (f32x2v){g01[i][0], g01[i][1]}); b1 = cmul(b1, (f32x2v){g01[i][2], g01[i][3]}); b2 = cmul(b2, (f32x2v){g23[i][0], g23[i][1]}); b3 = cmul(b3, (f32x2v){g23[i][2], g23[i][3]});
                const f32x2v c0 = b0 + b1, c1 = b0 - b1, c2 = b2 + b3, c3 = b2 - b3; const f32x2v t = {-c3.y, c3.x};
                b0 = c0 + c2; b2 = c0 - c2; b1 = c1 + t; b3 = c1 - t;
            }
            *(f32x4*)bp = (f32x4){b0.x, b0.y, b1.x, b1.y}; *(f32x4*)(bp + 2) = (f32x4){b2.x, b2.y, b3.x, b3.y}; }
    }
    __syncthreads();
}
__device__ __forceinline__ int brev14(int x) { return (int)(__brev((unsigned)x) >> 18); }
__device__ __forceinline__ void hy_fft(KPR p, int layer, unsigned char* smem) {
    f32x2v* buf = (f32x2v*)smem;
    f32x4* sW3 = (f32x4*)(smem + 139264); float* sDec = (float*)(smem + 139264 + 1024);
    f32x2v* Gs = (f32x2v*)(p.ws + WS_XN) + (size_t)blockIdx.x * 32768;
    f32x2v* Zs = (f32x2v*)(p.ws + WS_PROJ + (size_t)32768 * 2048 * 2) + (size_t)blockIdx.x * 8192;
    bf16_t* hyT = (bf16_t*)(p.ws + WS_AUX); const float* hid = (const float*)(p.ws + WS_HID) + (size_t)layer * 8192 * 64;
    const int tid = ltid();
    for (int c = blockIdx.x; c < 512; c += gridDim.x) {
        if (tid < 256) ((float*)sW3)[tid] = p.in[I_HYW3][(size_t)layer * 64 * 2048 + (tid >> 2) * 2048 + (tid & 3) * 512 + c];
        if (tid < 4) sDec[tid] = p.in[I_HYDECAY][layer * 2048 + tid * 512 + c];
        __syncthreads();
#ifndef REP_FILT
#define REP_FILT 1
#endif
#ifndef REP_CONV1
#define REP_CONV1 1
#endif
        for (int frep = 0; frep < REP_FILT; ++frep) {
#pragma unroll 1
        for (int i = 0; i < 4; ++i) { const int t = 4 * (tid + 512 * i); const float* hp = hid + t; f32x4 a0 = {0.f, 0.f, 0.f, 0.f}, a1 = a0, a2 = a0, a3 = a0;
#pragma unroll 1
            for (int kb = 0; kb < 64; kb += 32) { f32x4 hv[32];
#pragma unroll
                for (int k = 0; k < 32; ++k) hv[k] = *(const f32x4*)(hp + (size_t)(kb + k) * 8192);
#pragma unroll
                for (int k = 0; k < 32; ++k) { const f32x4 w = sW3[kb + k]; a0 += hv[k] * w[0]; a1 += hv[k] * w[1]; a2 += hv[k] * w[2]; a3 += hv[k] * w[3]; } }
#pragma unroll
            for (int e = 0; e < 4; ++e) { const int te = t + e; const float tn = (float)te * (1.0f / 8192.0f);
                buf[PIDX(te)] = (f32x2v){a0[e] * __expf(-tn * sDec[0]), a2[e] * __expf(-tn * sDec[2])};
                if (te >= 1) buf[PIDX(16384 - te)] = (f32x2v){a1[e] * __expf(-tn * sDec[1]), a3[e] * __expf(-tn * sDec[3])}; else buf[PIDX(8192)] = (f32x2v){0.f, 0.f}; } }
        __syncthreads();
        r16_pass<1024, false>(buf); r16_pass<64, false>(buf); r16_pass<4, false>(buf); r4_mid<0>(buf, nullptr);
        const float skip0 = p.in[I_HYSKIP][layer * 1024 + c], skip1 = p.in[I_HYSKIP][layer * 1024 + 512 + c];
#pragma unroll 4
        for (int r = 0; r < 32; ++r) { const int pz = tid + 512 * r, k = brev14(pz), pm = brev14((16384 - k) & 16383);
            const f32x2v Z = buf[PIDX(pz)], Zm = buf[PIDX(pm)]; const float hs = 0.5f / 16384.0f;
            Gs[pz] = (f32x2v){(Z.x + Zm.x) * hs + skip0 * (1.0f / 16384.0f), (Z.y - Zm.y) * hs}; Gs[16384 + pz] = (f32x2v){(Z.y + Zm.y) * hs + skip1 * (1.0f / 16384.0f), (Zm.x - Z.x) * hs}; }
        __syncthreads(); }
#pragma unroll 1
        for (int pr = 0; pr < 2; ++pr) {
            bf16_t* v0 = hyT + ((size_t)c * 4 + 2 * pr) * SEQ; bf16_t* v1 = v0 + SEQ;
            const bf16_t* p0 = hyT + ((size_t)(512 + c) * 4 + 2 * pr) * SEQ; const bf16_t* p1 = p0 + SEQ;
            const bf16_t* q0 = hyT + ((size_t)(1024 + c) * 4 + 2 * pr) * SEQ; const bf16_t* q1 = q0 + SEQ;
            u32x4 uv0[2], uv1[2], ux0[2], ux1[2], uy0[2], uy1[2];
#pragma unroll
            for (int r = 0; r < 2; ++r) { const int t0 = 8 * (tid + 512 * r); uv0[r] = *(const u32x4*)(v0 + t0); uv1[r] = *(const u32x4*)(v1 + t0);
                ux0[r] = *(const u32x4*)(p0 + t0); ux1[r] = *(const u32x4*)(p1 + t0); uy0[r] = *(const u32x4*)(q0 + t0); uy1[r] = *(const u32x4*)(q1 + t0); }
            for (int crep = 0; crep < REP_CONV1; ++crep) {
#pragma unroll
            for (int r = 0; r < 2; ++r) { const int t0 = 8 * (tid + 512 * r); float a[8], b[8]; unpack8(uv0[r], a); unpack8(uv1[r], b);
                f32x4* bp = (f32x4*)(buf + PIDX(t0)); f32x4* bz = (f32x4*)(buf + PIDX(8192 + t0));
#pragma unroll
                for (int e = 0; e < 4; ++e) { bp[e] = (f32x4){a[2 * e], b[2 * e], a[2 * e + 1], b[2 * e + 1]}; bz[e] = (f32x4){0.f, 0.f, 0.f, 0.f}; } }
            __syncthreads();
            r16_pass<1024, false>(buf); r16_pass<64, false>(buf); r16_pass<4, false>(buf); r4_mid<1>(buf, Gs);
            r16_pass<4, true>(buf); r16_pass<64, true>(buf); r16_pass<1024, true>(buf);
#pragma unroll
            for (int r = 0; r < 2; ++r) { const int t0 = 8 * (tid + 512 * r); float a[8], b[8], xa[8], xb[8];
                unpack8(uv0[r], a); unpack8(uv1[r], b); unpack8(ux0[r], xa); unpack8(ux1[r], xb);
                f32x4* bp = (f32x4*)(buf + PIDX(t0)); f32x4* bz = (f32x4*)(buf + PIDX(8192 + t0));
#pragma unroll
                for (int e = 0; e < 4; ++e) { const f32x4 cv = bp[e];
                    const f32x4 z = {xa[2 * e] * cv[0], xb[2 * e] * cv[1], xa[2 * e + 1] * cv[2], xb[2 * e + 1] * cv[3]};
                    bp[e] = z; bz[e] = (f32x4){0.f, 0.f, 0.f, 0.f}; } }
            __syncthreads(); }
            r16_pass<1024, false>(buf); r16_pass<64, false>(buf); r16_pass<4, false>(buf); r4_mid<1>(buf, Gs + 16384);
            r16_pass<4, true>(buf); r16_pass<64, true>(buf); r16_pass<1024, true>(buf);
#pragma unroll
            for (int r = 0; r < 2; ++r) { const int t0 = 8 * (tid + 512 * r); float xa[8], xb[8], ya[8], yb[8];
                unpack8(uy0[r], xa); unpack8(uy1[r], xb);
                const f32x4* bp = (const f32x4*)(buf + PIDX(t0));
#pragma unroll
                for (int e = 0; e < 4; ++e) { const f32x4 cv = bp[e];
                    ya[2 * e] = xa[2 * e] * cv[0]; yb[2 * e] = xb[2 * e] * cv[1]; ya[2 * e + 1] = xa[2 * e + 1] * cv[2]; yb[2 * e + 1] = xb[2 * e + 1] * cv[3]; }
                *(u32x4*)(v0 + t0) = pack8(ya); *(u32x4*)(v1 + t0) = pack8(yb); }
            __syncthreads();
        }
    }
}
__global__ void __launch_bounds__(512) hybrid_fwd(Params p_unused) {
#define p (*kp())
    extern __shared__ __attribute__((aligned(16))) unsigned char smem[];
    cg::grid_group grid = cg::this_grid();
    volatile LAS unsigned* bst = (volatile LAS unsigned*)(smem + LDS_BYTES - 16);
    if (threadIdx.x < 4) bst[threadIdx.x] = 0u;
    __syncthreads();
    (void)xcd_barrier_post((unsigned*)(p.ws + WS_BAR), bst);
#define GSYNC() do { unsigned _z = 0u; asm volatile("" : "+v"(_z)); unsigned* _bar = (unsigned*)(p.ws + WS_BAR) + _z; XcdBarrier _b; _b.bar = _bar; _b.x = xb_xcc_id(); _b.st = bst; xcd_barrier(_b); } while (0)
    bf16_t* WBT = (bf16_t*)(p.ws + WS_WBT); bf16_t* WOT = (bf16_t*)(p.ws + WS_WOT); bf16_t* XN = (bf16_t*)(p.ws + WS_XN); float* SPEC = (float*)(p.ws + WS_SPEC);
    bf16_t* Yb = (bf16_t*)(p.ws + WS_Y); bf16_t* PROJ = (bf16_t*)(p.ws + WS_PROJ);
    for (int l = 0; l < 2; ++l) {
        conv_wt(p.in[I_WIN] + (size_t)l * 1024 * 8224, 1024, 8224, WBT + (size_t)l * 8224 * 1024, 8224, 1, smem);
        conv_wt(p.in[I_WOUT] + (size_t)l * 2048 * 1024, 2048, 1024, WOT + (size_t)l * 1024 * 2048, 1024, 0, smem);
    }
    hid_phase(p, smem);
    if (p.ws == nullptr) grid.sync();
    GSYNC();
#ifndef REP_M1A
#define REP_M1A 1
#endif
#ifndef REP_M3A
#define REP_M3A 1
#endif
#ifndef REP_M1B
#define REP_M1B 1
#endif
#ifndef REP_M3B
#define REP_M3B 1
#endif
#ifndef REP_POST
#define REP_POST 1
#endif
#ifndef REP_NORM
#define REP_NORM 1
#endif
#ifndef REP_GEMM
#define REP_GEMM 1
#endif
#ifndef REP_MB
#define REP_MB 1
#endif
#ifndef REP_ML
#define REP_ML 1
#endif
#ifndef REP_NA
#define REP_NA 1
#endif
#ifndef REP_HY
#define REP_HY 1
#endif
#ifndef REP_SYNC
#define REP_SYNC 0
#endif
    for (int l = 0; l < 2; ++l) {
        const float* xin = (l == 0) ? p.in[I_X] : p.out;
        const bf16_t* Wl = WBT + (size_t)l * 8224 * 1024;
        for (int r6 = 0; r6 < REP_NORM; ++r6) { norm_phase(xin, p.in[I_NORMW] + l * 1024, Wl + (size_t)8192 * 1024, XN, SPEC, smem);
        GSYNC(); }
        for (int rep = 0; rep < REP_GEMM; ++rep) { run_gemm(smem, XN, Wl + (size_t)2048 * 1024, NTOK, 1536, 1024, EpiProj{PROJ, 1536});
        GSYNC(); }
        for (int rep = 0; rep < REP_MB; ++rep) {
        for (int r1 = 0; r1 < REP_M1A; ++r1) { ssd_m1<0>(p, l, smem); GSYNC(); }
        ssd_m2<0>(p); GSYNC();
        for (int r3 = 0; r3 < REP_M3A; ++r3) { ssd_m3_mamba(p, l, smem); GSYNC(); } }
        for (int rep = 0; rep < REP_SYNC; ++rep) GSYNC();
        for (int rep = 0; rep < REP_GEMM; ++rep) { run_gemm(smem, XN, Wl + (size_t)3584 * 1024, NTOK, 2560, 1024, EpiProj{PROJ, 2560});
        GSYNC(); }
        for (int rep = 0; rep < REP_ML; ++rep) {
        for (int r1 = 0; r1 < REP_M1B; ++r1) { ssd_m1<1>(p, l, smem); GSYNC(); }
        ssd_m2<1>(p); GSYNC();
        for (int r3 = 0; r3 < REP_M3B; ++r3) { ssd_m3<1>(p, l, smem); GSYNC(); } }
        for (int rep = 0; rep < REP_GEMM; ++rep) { run_gemm(smem, XN, Wl + (size_t)6144 * 1024, NTOK, 2048, 1024, EpiProj{PROJ, 2048});
        GSYNC(); }
        for (int rep = 0; rep < REP_NA; ++rep) { na_phase(p, l, smem); GSYNC(); }
        for (int rep = 0; rep < REP_GEMM; ++rep) { run_gemm(smem, XN, Wl, NTOK, 2048, 1024, EpiProj{PROJ, 2048});
        GSYNC(); }
#ifndef REP_HYPREP
#define REP_HYPREP 1
#endif
        for (int rep = 0; rep < REP_HY; ++rep) {
        for (int rep2 = 0; rep2 < REP_HYPREP; ++rep2) { hy_prep(p, l, smem); GSYNC(); }
        hy_fft(p, l, smem); GSYNC(); }
        for (int r5 = 0; r5 < REP_POST; ++r5) { hy_post(p, smem); GSYNC(); }
        run_gemm(smem, Yb, WOT + (size_t)l * 1024 * 2048, NTOK, 1024, 2048, EpiResid{p.out, xin, 1024});
        if (l == 0) GSYNC();
    }
}

#undef p
extern "C" void kernel_launch(void* const* d_in, const int* in_sizes, int n_in, void* d_out, int out_size, void* d_ws, size_t ws_size, hipStream_t stream) {
    static int grid = 0;
    if (grid == 0) {
        if (n_in != 27 || ws_size < WS_END) { fprintf(stderr, "kernel_launch: need 27 inputs and %zu bytes of workspace (got %d, %zu)\n", (size_t)WS_END, n_in, ws_size); grid = -1; return; }
        int dev = 0, cus = 0, per_cu = 0;
        hipGetDevice(&dev); hipDeviceGetAttribute(&cus, hipDeviceAttributeMultiprocessorCount, dev);
        if (hipFuncSetAttribute((const void*)hybrid_fwd, hipFuncAttributeMaxDynamicSharedMemorySize, LDS_BYTES) != hipSuccess) { fprintf(stderr, "kernel_launch: hipFuncSetAttribute failed\n"); grid = -1; return; }
        if (hipOccupancyMaxActiveBlocksPerMultiprocessor(&per_cu, (const void*)hybrid_fwd, 512, LDS_BYTES) != hipSuccess || per_cu < 1) { fprintf(stderr, "kernel_launch: occupancy query failed (%d)\n", per_cu); grid = -1; return; }
        grid = cus * per_cu; if (grid > 256) grid = 256;
    }
    if (grid < 0) return;
    if (hipMemsetAsync((char*)d_ws + WS_BAR, 0, 16384, stream) != hipSuccess) { fprintf(stderr, "kernel_launch: memset of barrier words failed\n"); return; }
    Params p{};
    for (int i = 0; i < 27; ++i) p.in[i] = (const float*)d_in[i];
    p.out = (float*)d_out; p.ws = (unsigned char*)d_ws;
    void* args[] = {&p};
    hipError_t e = hipLaunchCooperativeKernel((const void*)hybrid_fwd, dim3(grid), dim3(512), args, LDS_BYTES, stream);
    if (e != hipSuccess) fprintf(stderr, "cooperative launch failed: %s (grid %d)\n", hipGetErrorString(e), grid);
}
```

```cpp
#include <hip/hip_runtime.h>
#include <hip/hip_cooperative_groups.h>
#include <cstdio>
namespace cg = cooperative_groups;
__device__ __forceinline__ int ltid() { int t = threadIdx.x; asm volatile("" : "+v"(t)); return t; }

#define XB_TMO      128
#define XB_XCNT(j)  (256  + 64 * (j))
#define XB_XSUB(j)  (1280 + 64 * (j))
#define XB_XGEN(j)  (2304 + 64 * (j))
#define XB_TOP      3328
#define XB_TOPGEN   3392
#define XCD_BAR_WORDS 3456
#define XB_SPIN_CAP (1u << 18)
#define LAS __attribute__((address_space(3)))

__device__ __forceinline__ unsigned xb_ld(unsigned* p)              { return __hip_atomic_load(p, __ATOMIC_RELAXED, __HIP_MEMORY_SCOPE_AGENT); }
__device__ __forceinline__ unsigned xb_add(unsigned* p, unsigned v) { return __hip_atomic_fetch_add(p, v, __ATOMIC_RELAXED, __HIP_MEMORY_SCOPE_AGENT); }
__device__ __forceinline__ unsigned xb_xcc_id() { return (unsigned)__builtin_amdgcn_s_getreg((3 << 11) | 20) & 0xFu; }
#define XB_SPIN(cond, bar) do { unsigned _sp = 0; while (cond) { __builtin_amdgcn_s_sleep(1); \
    if ((++_sp & 255u) == 0u) { if (xb_ld(&(bar)[XB_TMO])) break; if (_sp > XB_SPIN_CAP) { atomicAdd(&(bar)[XB_TMO], 1u); break; } } } } while (0)

struct XcdBarrier {
    unsigned* bar; unsigned x;
    volatile LAS unsigned* st;
};

__device__ __forceinline__ XcdBarrier xcd_barrier_post(unsigned* bar, volatile LAS unsigned* st) {
    XcdBarrier b; b.bar = bar; b.x = xb_xcc_id(); b.st = st;
    if (threadIdx.x == 0) (void)xb_add(&bar[XB_XCNT(b.x)], 1u);
    return b;
}
__device__ __forceinline__ void xcd_barrier_complete(unsigned* bar, unsigned x, unsigned& nloc, unsigned& nx) {
    const unsigned G = gridDim.x * gridDim.y * gridDim.z;
    unsigned sum, cnt, mine, sp = 0u;
    for (;;) {
        sum = 0u; cnt = 0u; mine = 0u;
#pragma unroll
        for (unsigned j = 0; j < 16; ++j) { const unsigned c = xb_ld(&bar[XB_XCNT(j)]); sum += c; cnt += (c > 0u) ? 1u : 0u; mine = (j == x) ? c : mine; }
        if (sum == G) break;
        __builtin_amdgcn_s_sleep(1);
        if ((++sp & 255u) == 0u) { if (xb_ld(&bar[XB_TMO])) break; if (sp > XB_SPIN_CAP) { atomicAdd(&bar[XB_TMO], 1u); break; } }
    }
    nloc = mine > 0u ? mine : 1u; nx = cnt > 0u ? cnt : 1u;
}

__device__ __forceinline__ void xcd_barrier(const XcdBarrier& b) {
    asm volatile("s_waitcnt vmcnt(0)" ::: "memory");
    __syncthreads();
    if (threadIdx.x == 0) {
        unsigned* bar = b.bar;
        __builtin_amdgcn_s_waitcnt(0);
        unsigned nloc = b.st[0], nx = b.st[1];
        if (nloc == 0u) { xcd_barrier_complete(bar, b.x, nloc, nx); b.st[0] = nloc; b.st[1] = nx; }
        const unsigned old = xb_add(&bar[XB_XSUB(b.x)], 1u);
        const unsigned gen = old / nloc;
        if (old + 1u == (gen + 1u) * nloc) {
            __builtin_amdgcn_fence(__ATOMIC_RELEASE, "agent");
            asm volatile("s_waitcnt vmcnt(0)" ::: "memory");
            const unsigned og = xb_add(&bar[XB_TOP], 1u);
            const unsigned tg = og / nx;
            if (og + 1u == (tg + 1u) * nx) xb_add(&bar[XB_TOPGEN], 1u);
            else XB_SPIN(xb_ld(&bar[XB_TOPGEN]) == tg, bar);
            __builtin_amdgcn_fence(__ATOMIC_ACQUIRE, "agent");
            xb_add(&bar[XB_XGEN(b.x)], 1u);
            asm volatile("s_waitcnt vmcnt(0)" ::: "memory");
        } else {
            XB_SPIN(xb_ld(&bar[XB_XGEN(b.x)]) == gen, bar);
            __builtin_amdgcn_fence(__ATOMIC_ACQUIRE, "agent");
            asm volatile("s_waitcnt vmcnt(0)" ::: "memory");
        }
    }
    __syncthreads();
}
namespace pg8 {
#define PG8_LAS __attribute__((address_space(3)))
typedef unsigned short bf16_t;
typedef short bf16x8 __attribute__((ext_vector_type(8)));
typedef float f32x4 __attribute__((ext_vector_type(4)));
typedef unsigned u32x4 __attribute__((ext_vector_type(4)));
constexpr int BM = 256, BK = 64, HALF = 128, HTB = HALF * BK * 2  , STAGE_BYTES = 8 * HTB, NXCD = 8, WGM = 8;

__host__ __device__ __forceinline__ int lds_byte(int r, int c) { const int st = (r >> 4) * 2 + (c >> 5), rr = r & 15, cc = c & 31, ob = rr * 64 + cc * 2; return st * 1024 + (ob ^ (((ob >> 9) & 1) << 5)); }
__host__ __device__ __forceinline__ void stage_rc(int b, int& R, int& C) { const int st = b / 1024, sb = b % 1024, swz = sb ^ (((sb >> 9) & 1) << 5); R = (st >> 1) * 16 + swz / 64; C = (st & 1) * 32 + (swz % 64) / 2; }
__host__ __device__ __forceinline__ int perm32(int rho) { const int n = rho >> 4, i = rho & 15; return 8 * (i >> 2) + 4 * n + (i & 3); }

struct Unit { int pm, pn; };
struct Gemm { const bf16_t* A; const bf16_t* Bt; int M, N, K; };

struct StaticOrder {
    int nM, nN, nwg, G, c;
    __host__ __device__ void init(int M, int N, int G_, int c_) { nM = M / BM; nN = N / BM; nwg = nM * nN; G = G_; c = c_; }
    __host__ __device__ bool next(int i, Unit& u) const {
        const long L = (long)i * G + c; if (L >= nwg) return false;
        int wgid = (int)L; { const int q = nwg / NXCD, r = nwg % NXCD, xcd = wgid % NXCD, off = wgid / NXCD; wgid = (xcd < r ? xcd * (q + 1) : r * (q + 1) + (xcd - r) * q) + off; }
        const int nig = WGM * nN, gid = wgid / nig, fm = gid * WGM, gsz = (nM - fm) < WGM ? (nM - fm) : WGM;
        u.pm = fm + ((wgid % nig) % gsz); u.pn = (wgid % nig) / gsz; return true;
    }
    __device__ __forceinline__ void a_ready(const Unit&) const {}
    __device__ __forceinline__ void done(const Unit&) const {}
};
__device__ __forceinline__ unsigned cvt_pk_bf16(float lo, float hi) { unsigned r; asm volatile("v_cvt_pk_bf16_f32 %0, %1, %2" : "=v"(r) : "v"(lo), "v"(hi)); return r; }
template <class Epi, class Sched, bool ALIGN_EPI = false, bool SP2 = false>
__device__ __forceinline__ void gemm_phase(PG8_LAS unsigned char* lds, const Gemm g, const Sched& S, const Epi& E) {
    const int tid = ltid(), wid = __builtin_amdgcn_readfirstlane(tid >> 6), lane = tid & 63, wr = wid >> 2, wc = wid & 3, fr = lane & 15, fq = lane >> 4;
    const int K = g.K, nt = K / BK;
    unsigned voffA[2], voffB[2];
#pragma unroll
    for (int i = 0; i < 2; ++i) { int R, C; stage_rc(tid * 16 + i * 8192, R, C); const int Rb = Epi::PERM ? ((R & ~31) + perm32(R & 31)) : R;
        voffA[i] = (unsigned)(R * K + C) * 2u; voffB[i] = (unsigned)(Rb * K + C) * 2u; }
    const size_t kstep = (size_t)(BK * 2);
    const size_t hstep = (size_t)HALF * K * 2;
    const size_t tstep = 2 * hstep;
    const unsigned ldsw = (unsigned)wid * 1024u;
    const int aoff = lds_byte(wr * 64 + fr, fq * 8), boff = lds_byte(wc * 32 + fr, fq * 8);
#define PG8_SA(b, h) (((b) * 2 + (h)) * HTB)
#define PG8_SB(b, h) ((4 + (b) * 2 + (h)) * HTB)
#define PG8_STAGE(bufoff, gbase, voff) do { _Pragma("unroll") for (int _i = 0; _i < 2; ++_i) \
        __builtin_amdgcn_global_load_lds((const unsigned*)((const char*)(gbase) + (voff)[_i]), (PG8_LAS unsigned*)(lds + (bufoff) + ldsw + _i * 8192), 16, 0, 0); } while (0)
#define PG8_LDA(dst, b, h) do { _Pragma("unroll") for (int m = 0; m < 4; ++m) _Pragma("unroll") for (int k = 0; k < 2; ++k) dst[m][k] = *(const PG8_LAS bf16x8*)(lds + PG8_SA(b, h) + aoff + m * 2048 + k * 1024); } while (0)
#define PG8_LDB(dst, b, h) do { _Pragma("unroll") for (int n = 0; n < 2; ++n) _Pragma("unroll") for (int k = 0; k < 2; ++k) dst[n][k] = *(const PG8_LAS bf16x8*)(lds + PG8_SB(b, h) + boff + n * 2048 + k * 1024); } while (0)
#define PG8_MMA(ai, bj, At, Bt) do { __builtin_amdgcn_s_setprio(1); _Pragma("unroll") for (int m = 0; m < 4; ++m) _Pragma("unroll") for (int n = 0; n < 2; ++n) _Pragma("unroll") for (int k = 0; k < 2; ++k) \
        acc[ai][bj][m][n] = __builtin_amdgcn_mfma_f32_16x16x32_bf16(Bt[n][k], At[m][k], acc[ai][bj][m][n], 0, 0, 0); __builtin_amdgcn_s_setprio(0); } while (0)
#define PG8_WAIT_V(n) asm volatile("s_waitcnt vmcnt(" #n ")" ::: "memory")
#define PG8_WAIT_L(n) asm volatile("s_waitcnt lgkmcnt(" #n ")" ::: "memory")
#define PG8_BAR __builtin_amdgcn_s_barrier()
#define PG8_SCHED __builtin_amdgcn_sched_barrier(0)
    Unit cur, nxt; int ui = 0;
    if (!S.next(0, cur)) return;
    f32x4 acc[2][2][4][2];
#pragma unroll
    for (int a = 0; a < 2; ++a)
#pragma unroll
        for (int b = 0; b < 2; ++b)
#pragma unroll
            for (int m = 0; m < 4; ++m)
#pragma unroll
                for (int n = 0; n < 2; ++n) acc[a][b][m][n] = (f32x4){0.f, 0.f, 0.f, 0.f};
    bf16x8 At[4][2], B0[2][2], B1[2][2];
    const char* cA = (const char*)g.A + (size_t)cur.pm * tstep; const char* cB = (const char*)g.Bt + (size_t)cur.pn * tstep;
    S.a_ready(cur);
    if constexpr (SP2) {
        PG8_STAGE(PG8_SB(0, 0), cB, voffB); PG8_STAGE(PG8_SB(0, 1), cB + hstep, voffB); PG8_STAGE(PG8_SA(0, 0), cA, voffA); PG8_STAGE(PG8_SA(0, 1), cA + hstep, voffA);
        if (wr == 1) PG8_BAR;
        PG8_WAIT_V(2); PG8_BAR;
        PG8_STAGE(PG8_SB(1, 0), cB + kstep, voffB); PG8_STAGE(PG8_SA(1, 0), cA + kstep, voffA); PG8_STAGE(PG8_SB(1, 1), cB + hstep + kstep, voffB);
        PG8_WAIT_V(6); PG8_BAR;
    } else {
        PG8_STAGE(PG8_SB(0, 0), cB, voffB); PG8_STAGE(PG8_SA(0, 0), cA, voffA); PG8_STAGE(PG8_SB(0, 1), cB + hstep, voffB); PG8_STAGE(PG8_SA(0, 1), cA + hstep, voffA);
        if (wr == 1) PG8_BAR;
        PG8_WAIT_V(4); PG8_BAR;
        PG8_STAGE(PG8_SB(1, 0), cB + kstep, voffB); PG8_STAGE(PG8_SA(1, 0), cA + kstep, voffA); PG8_STAGE(PG8_SB(1, 1), cB + hstep + kstep, voffB);
        PG8_WAIT_V(6); PG8_BAR;
    }
    for (;;) {
        const bool has_next = S.next(ui + 1, nxt);
        const char* nA = has_next ? (const char*)g.A + (size_t)nxt.pm * tstep : cA; const char* nB = has_next ? (const char*)g.Bt + (size_t)nxt.pn * tstep : cB;
        for (int t = 0; t < nt; t += 2) {
            const bool last = (t == nt - 2);
            const char* a1 = cA + (size_t)(t + 1) * kstep;
            const char* a2 = last ? nA : cA + (size_t)(t + 2) * kstep; const char* b2 = last ? nB : cB + (size_t)(t + 2) * kstep;
            const char* a3 = a2 + kstep; const char* b3 = b2 + kstep;
            if (last && has_next) S.a_ready(nxt);
            if constexpr (SP2) {
            PG8_LDB(B0, 0, 0); PG8_LDB(B1, 0, 1); PG8_SCHED; PG8_LDA(At, 0, 0); PG8_STAGE(PG8_SA(1, 1), a1 + hstep, voffA);
            PG8_WAIT_V(8); PG8_WAIT_L(0); PG8_BAR; PG8_MMA(0, 0, At, B0); PG8_MMA(0, 1, At, B1); PG8_BAR; PG8_SCHED;
            PG8_LDA(At, 0, 1); PG8_STAGE(PG8_SB(0, 0), b2, voffB); PG8_STAGE(PG8_SB(0, 1), b2 + hstep, voffB); PG8_STAGE(PG8_SA(0, 0), a2, voffA);
            PG8_WAIT_V(8); PG8_WAIT_L(0); PG8_BAR; PG8_MMA(1, 0, At, B0); PG8_MMA(1, 1, At, B1); PG8_BAR; PG8_SCHED;
            PG8_LDB(B0, 1, 0); PG8_LDB(B1, 1, 1); PG8_SCHED; PG8_LDA(At, 1, 0); PG8_STAGE(PG8_SA(0, 1), a2 + hstep, voffA);
            PG8_WAIT_V(8); PG8_WAIT_L(0); PG8_BAR; PG8_MMA(0, 0, At, B0); PG8_MMA(0, 1, At, B1); PG8_BAR; PG8_SCHED;
            PG8_LDA(At, 1, 1); PG8_STAGE(PG8_SB(1, 0), b3, voffB); PG8_STAGE(PG8_SB(1, 1), b3 + hstep, voffB); PG8_STAGE(PG8_SA(1, 0), a3, voffA);
            PG8_WAIT_V(8); PG8_WAIT_L(0); PG8_BAR; PG8_MMA(1, 0, At, B0); PG8_MMA(1, 1, At, B1); PG8_BAR; PG8_SCHED;
            } else {
            PG8_LDB(B0, 0, 0); PG8_SCHED; PG8_LDA(At, 0, 0); PG8_STAGE(PG8_SA(1, 1), a1 + hstep, voffA);
            PG8_WAIT_L(8); PG8_BAR; PG8_WAIT_L(0); PG8_MMA(0, 0, At, B0); PG8_BAR; PG8_SCHED;
            PG8_LDB(B1, 0, 1); PG8_STAGE(PG8_SB(0, 0), b2, voffB);
            PG8_BAR; PG8_WAIT_L(0); PG8_MMA(0, 1, At, B1); PG8_BAR;
            PG8_LDA(At, 0, 1); PG8_STAGE(PG8_SA(0, 0), a2, voffA);
            PG8_BAR; PG8_WAIT_L(0); PG8_MMA(1, 0, At, B0); PG8_BAR; PG8_SCHED;
            PG8_STAGE(PG8_SB(0, 1), b2 + hstep, voffB);
            PG8_WAIT_V(6); PG8_BAR; PG8_MMA(1, 1, At, B1); PG8_BAR;
            PG8_LDB(B0, 1, 0); PG8_SCHED; PG8_LDA(At, 1, 0); PG8_STAGE(PG8_SA(0, 1), a2 + hstep, voffA);
            PG8_WAIT_L(8); PG8_BAR; PG8_WAIT_L(0); PG8_MMA(0, 0, At, B0); PG8_BAR; PG8_SCHED;
            PG8_LDB(B1, 1, 1); PG8_STAGE(PG8_SB(1, 0), b3, voffB);
            PG8_BAR; PG8_WAIT_L(0); PG8_MMA(0, 1, At, B1); PG8_BAR;
            PG8_LDA(At, 1, 1); PG8_STAGE(PG8_SA(1, 0), a3, voffA);
            PG8_BAR; PG8_WAIT_L(0); PG8_MMA(1, 0, At, B0); PG8_BAR; PG8_SCHED;
            PG8_STAGE(PG8_SB(1, 1), b3 + hstep, voffB);
            PG8_WAIT_V(6); PG8_BAR; PG8_MMA(1, 1, At, B1); PG8_BAR;
            }
        }
        if constexpr (ALIGN_EPI) { if (wr == 0) PG8_BAR; }
        if constexpr (!Epi::AFTER_DRAIN) { E(acc, cur, wr, wc, fr, fq); S.done(cur); }
        if (!has_next) break;
#pragma unroll
        for (int a = 0; a < 2; ++a)
#pragma unroll
            for (int b = 0; b < 2; ++b)
#pragma unroll
                for (int m = 0; m < 4; ++m)
#pragma unroll
                    for (int n = 0; n < 2; ++n) acc[a][b][m][n] = (f32x4){0.f, 0.f, 0.f, 0.f};
        cur = nxt; cA = nA; cB = nB; ++ui;
        if constexpr (ALIGN_EPI) { if (wr == 1) PG8_BAR; }
    }
    PG8_WAIT_V(0);
    if constexpr (!ALIGN_EPI) { if (wr == 0) PG8_BAR; }
    PG8_BAR;
    if constexpr (Epi::AFTER_DRAIN) { E.fused(acc, cur, wr, wc, fr, fq, lds, wid, lane); S.done(cur); }
#undef PG8_SA
#undef PG8_SB
#undef PG8_STAGE
#undef PG8_LDA
#undef PG8_LDB
#undef PG8_MMA
#undef PG8_WAIT_V
#undef PG8_WAIT_L
#undef PG8_BAR
#undef PG8_SCHED
}
}
using pg8::bf16_t; using pg8::bf16x8; using pg8::f32x4; using pg8::u32x4;
typedef unsigned u32x2 __attribute__((ext_vector_type(2)));

constexpr int SEQ = 8192, NTOK = 32768;
constexpr int LDS_BYTES = 160 * 1024;
constexpr size_t WS_WBT  = 0;
constexpr size_t WS_WOT  = WS_WBT + (size_t)2 * 8224 * 1024 * 2;
constexpr size_t WS_HID  = WS_WOT + (size_t)2 * 1024 * 2048 * 2;
constexpr size_t WS_XN   = WS_HID + (size_t)2 * 8192 * 64 * 4;
constexpr size_t WS_SPEC = WS_XN + (size_t)32768 * 1024 * 2;
constexpr size_t WS_Y    = WS_SPEC + (size_t)32768 * 32 * 4;
constexpr size_t WS_PROJ = WS_Y + (size_t)32768 * 2048 * 2;
constexpr size_t WS_AUX  = WS_PROJ + (size_t)32768 * 2560 * 2;
constexpr size_t WS_ATOT = WS_AUX + (size_t)3 * 512 * 32768 * 2;
constexpr size_t WS_BAR  = WS_ATOT + 65536;
constexpr size_t WS_END  = WS_BAR + 16384;

struct Params { const float* in[27]; float* out; unsigned char* ws; };
#define KPR const __attribute__((address_space(4))) Params&
__device__ __forceinline__ const __attribute__((address_space(4))) Params* kp() { auto k = __builtin_amdgcn_kernarg_segment_ptr(); asm volatile("" : "+s"(k)); return (const __attribute__((address_space(4))) Params*)k; }
enum { I_X = 0, I_NORMW, I_WIN, I_WOUT, I_HYCW, I_HYCB, I_HYW1, I_HYB1, I_HYW2, I_HYB2, I_HYW3, I_HYFREQ, I_HYDECAY, I_HYSKIP, I_MBCW, I_MBCB, I_MBDTB, I_MBALOG, I_MBD, I_MBNW,
       I_MLCW, I_MLCB, I_MLGB, I_MLNW, I_NAQN, I_NAKN, I_NARPB };

__device__ __forceinline__ float bf2f(bf16_t b) { return __uint_as_float(((unsigned)b) << 16); }
typedef __bf16 bf16v2_t __attribute__((ext_vector_type(2)));
__device__ __forceinline__ unsigned pk2(float lo, float hi) { bf16v2_t v; v[0] = (__bf16)lo; v[1] = (__bf16)hi; return __builtin_bit_cast(unsigned, v); }
__device__ __forceinline__ bf16_t f2bf(float f) { return __builtin_bit_cast(bf16_t, (__bf16)f); }
template <int E> __device__ __forceinline__ float bfe(const u32x4& u) { const unsigned w = u[E >> 1]; return (E & 1) ? __uint_as_float(w & 0xffff0000u) : __uint_as_float(w << 16); }
__device__ __forceinline__ void unpack8(const u32x4& u, float (&v)[8]) { v[0] = bfe<0>(u); v[1] = bfe<1>(u); v[2] = bfe<2>(u); v[3] = bfe<3>(u); v[4] = bfe<4>(u); v[5] = bfe<5>(u); v[6] = bfe<6>(u); v[7] = bfe<7>(u); }
__device__ __forceinline__ u32x4 pack8(const float (&v)[8]) { u32x4 w; w.x = pk2(v[0], v[1]); w.y = pk2(v[2], v[3]); w.z = pk2(v[4], v[5]); w.w = pk2(v[6], v[7]); return w; }
__device__ __forceinline__ float rcp_f(float x) { return __builtin_amdgcn_rcpf(x); }
typedef __bf16 bf16v2d_t __attribute__((ext_vector_type(2)));
__device__ __forceinline__ float sumsq8(const u32x4& u, float acc) {
    acc = __builtin_amdgcn_fdot2_f32_bf16(__builtin_bit_cast(bf16v2d_t, u.x), __builtin_bit_cast(bf16v2d_t, u.x), acc, false); acc = __builtin_amdgcn_fdot2_f32_bf16(__builtin_bit_cast(bf16v2d_t, u.y), __builtin_bit_cast(bf16v2d_t, u.y), acc, false);
    acc = __builtin_amdgcn_fdot2_f32_bf16(__builtin_bit_cast(bf16v2d_t, u.z), __builtin_bit_cast(bf16v2d_t, u.z), acc, false); acc = __builtin_amdgcn_fdot2_f32_bf16(__builtin_bit_cast(bf16v2d_t, u.w), __builtin_bit_cast(bf16v2d_t, u.w), acc, false); return acc; }
__device__ __forceinline__ float silu_f(float x) { return x * rcp_f(1.0f + __expf(-x)); }
__device__ __forceinline__ float sigmoid_f(float x) { return rcp_f(1.0f + __expf(-x)); }
__device__ __forceinline__ f32x4 mfma16(const bf16x8& a, const bf16x8& b, const f32x4& c) { return __builtin_amdgcn_mfma_f32_16x16x32_bf16(a, b, c, 0, 0, 0); }
__device__ __forceinline__ bf16x8 as_bf16x8(const u32x4& u) { union { u32x4 a; bf16x8 b; } x; x.a = u; return x.b; }
__device__ __forceinline__ int clampi(int v, int lo, int hi) { return v < lo ? lo : (v > hi ? hi : v); }

struct EpiProj {
    static constexpr bool PERM = true, AFTER_DRAIN = false;
    bf16_t* O; int ldc;
    __device__ __forceinline__ void operator()(const f32x4 (&acc)[2][2][4][2], const pg8::Unit& u, int wr, int wc, int fr, int fq) const {
        const int row0 = u.pm * 256 + wr * 64 + fr, col0 = u.pn * 256 + wc * 32 + 8 * fq;
#pragma unroll
        for (int ai = 0; ai < 2; ++ai)
#pragma unroll
            for (int m = 0; m < 4; ++m) { bf16_t* rowp = O + (size_t)(row0 + ai * 128 + m * 16) * ldc + col0;
#pragma unroll
                for (int bj = 0; bj < 2; ++bj) { const f32x4 v0 = acc[ai][bj][m][0], v1 = acc[ai][bj][m][1];
                    u32x4 w; w.x = pk2(v0[0], v0[1]); w.y = pk2(v0[2], v0[3]); w.z = pk2(v1[0], v1[1]); w.w = pk2(v1[2], v1[3]);
                    *(u32x4*)(rowp + bj * 128) = w; } }
    }
};
struct EpiResid {
    static constexpr bool PERM = false, AFTER_DRAIN = false;
    float* C; const float* R; int ldc;
    __device__ __forceinline__ void operator()(const f32x4 (&acc)[2][2][4][2], const pg8::Unit& u, int wr, int wc, int fr, int fq) const {
        const int row0 = u.pm * 256 + wr * 64 + fr, col0 = u.pn * 256 + wc * 32 + 4 * fq;
#pragma unroll
        for (int ai = 0; ai < 2; ++ai)
#pragma unroll
            for (int mp = 0; mp < 2; ++mp) { f32x4 rv[2][2][2];
#pragma unroll
                for (int mm = 0; mm < 2; ++mm) { const size_t off = (size_t)(row0 + ai * 128 + (mp * 2 + mm) * 16) * ldc + col0;
#pragma unroll
                    for (int bj = 0; bj < 2; ++bj)
#pragma unroll
                        for (int n = 0; n < 2; ++n) rv[mm][bj][n] = *(const f32x4*)(R + off + bj * 128 + n * 16); }
                asm volatile("" ::: "memory");
#pragma unroll
                for (int mm = 0; mm < 2; ++mm) { const size_t off = (size_t)(row0 + ai * 128 + (mp * 2 + mm) * 16) * ldc + col0;
#pragma unroll
                    for (int bj = 0; bj < 2; ++bj)
#pragma unroll
                        for (int n = 0; n < 2; ++n) *(f32x4*)(C + off + bj * 128 + n * 16) = rv[mm][bj][n] + acc[ai][bj][mp * 2 + mm][n]; }
                asm volatile("" ::: "memory"); }
    }
};
template <class Epi> __device__ __forceinline__ void run_gemm(unsigned char* smem, const bf16_t* A, const bf16_t* Bt, int M, int N, int K, const Epi& E) {
    pg8::Gemm g{A, Bt, M, N, K}; pg8::StaticOrder S; S.init(M, N, (int)gridDim.x, (int)blockIdx.x);
    pg8::gemm_phase<Epi, pg8::StaticOrder, true, true>((PG8_LAS unsigned char*)smem, g, S, E);
    __syncthreads();
}

__device__ __forceinline__ int win_col(int n) { return n < 3584 ? n : (n < 6144 ? n + 16 : (n < 8192 ? n + 32 : (n < 8208 ? n - 8192 + 3584 : n - 8208 + 6160))); }
__device__ __forceinline__ void conv_wt(const float* W, int K, int ldw, bf16_t* Bt, int nrows, int mapmode, unsigned char* smem) {
    float* tile = (float*)smem;
    const int tid = ltid(), ntn = nrows / 32, ntk = K / 128, ntot = ntn * ntk;
    for (int t0 = blockIdx.x * 4; t0 < ntot; t0 += gridDim.x * 4) {
        float v[4][8];
#pragma unroll
        for (int q = 0; q < 4; ++q) { const int t = t0 + q < ntot ? t0 + q : ntot - 1, tn = t % ntn, tk = t / ntn, n0 = tn * 32, k0 = tk * 128;
            const int nn = tid & 31, kk = tid >> 5, col = mapmode ? win_col(n0 + nn) : (n0 + nn);
#pragma unroll
            for (int i = 0; i < 8; ++i) v[q][i] = W[(size_t)(k0 + kk + 16 * i) * ldw + col]; }
#pragma unroll
        for (int q = 0; q < 4; ++q) { const int nn = tid & 31, kk = tid >> 5;
#pragma unroll
            for (int i = 0; i < 8; ++i) tile[q * 4128 + nn * 129 + kk + 16 * i] = v[q][i]; }
        __syncthreads();
#pragma unroll
        for (int q = 0; q < 4; ++q) if (t0 + q < ntot) { const int t = t0 + q, tn = t % ntn, tk = t / ntn, n0 = tn * 32, k0 = tk * 128; const int row = tid >> 4, kq = tid & 15; float o[8];
#pragma unroll
            for (int e = 0; e < 8; ++e) o[e] = tile[q * 4128 + row * 129 + kq * 8 + e];
            *(u32x4*)(Bt + (size_t)(n0 + row) * K + k0 + kq * 8) = pack8(o); }
        __syncthreads();
    }
}
__device__ __forceinline__ void hid_phase(KPR p, unsigned char* smem) {
    float* sF = (float*)smem; float* sH = sF + 8 * 20;
    float* hid = (float*)(p.ws + WS_HID);
    const int tid = ltid(), r = tid >> 6, j = tid & 63;
    int curl = -1; float w1r[17], w2r[64], fq = 0.f, b1 = 0.f, b2 = 0.f;
    for (int it = blockIdx.x; it < 2048; it += gridDim.x) {
        const int row = it * 8 + r, l = row >> 13, t = row & 8191;
        if (l != curl) { curl = l; fq = p.in[I_HYFREQ][l * 64 + j]; b1 = p.in[I_HYB1][l * 64 + j]; b2 = p.in[I_HYB2][l * 64 + j];
#pragma unroll
            for (int i = 0; i < 17; ++i) w1r[i] = p.in[I_HYW1][l * 17 * 64 + i * 64 + j];
#pragma unroll
            for (int k = 0; k < 64; ++k) w2r[k] = p.in[I_HYW2][l * 64 * 64 + k * 64 + j]; }
        if (j < 17) { float v;
            if (j == 0) v = (float)t * (1.0f / 8192.0f);
            else { const int band = (j <= 8) ? j : j - 8; const float fr = (float)((t * band) & 8191) * (1.0f / 8192.0f); v = (j <= 8) ? __builtin_amdgcn_cosf(fr) : __builtin_amdgcn_sinf(fr); }
            sF[r * 20 + j] = v; }
        __syncthreads();
        { float a = b1;
#pragma unroll
          for (int i = 0; i < 17; ++i) a += sF[r * 20 + i] * w1r[i];
          sH[r * 64 + j] = __sinf(fq * a); }
        __syncthreads();
        { float a = b2;
#pragma unroll
          for (int k4 = 0; k4 < 16; ++k4) { const f32x4 hv = *(const f32x4*)(sH + r * 64 + k4 * 4); a += hv[0] * w2r[k4 * 4] + hv[1] * w2r[k4 * 4 + 1] + hv[2] * w2r[k4 * 4 + 2] + hv[3] * w2r[k4 * 4 + 3]; }
          hid[((size_t)(l * 64 + j)) * 8192 + t] = __sinf(fq * a); }
        __syncthreads();
    }
}

__device__ __forceinline__ void norm_phase(const float* xin, const float* nw, const bf16_t* wsp, bf16_t* xn, float* spec, unsigned char* smem) {
    bf16_t* sA = (bf16_t*)smem;
    const int tid = ltid(), wid = tid >> 6, lane = tid & 63;
    f32x4 nwv[4];
#pragma unroll
    for (int i = 0; i < 4; ++i) nwv[i] = *(const f32x4*)(nw + lane * 4 + 256 * i);
    for (int it = blockIdx.x; it < 512; it += gridDim.x) {
        const int row0 = it * 64;
#pragma unroll 1
        for (int rb = 0; rb < 2; ++rb) {
            f32x4 v[4][4];
#pragma unroll
            for (int rr = 0; rr < 4; ++rr) { const float* xr = xin + (size_t)(row0 + wid * 8 + rb * 4 + rr) * 1024;
#pragma unroll
                for (int i = 0; i < 4; ++i) v[rr][i] = *(const f32x4*)(xr + lane * 4 + 256 * i); }
#pragma unroll
            for (int rr = 0; rr < 4; ++rr) { const int r = wid * 8 + rb * 4 + rr; float ss = 0.f;
#pragma unroll
                for (int i = 0; i < 4; ++i) ss += v[rr][i][0] * v[rr][i][0] + v[rr][i][1] * v[rr][i][1] + v[rr][i][2] * v[rr][i][2] + v[rr][i][3] * v[rr][i][3];
#pragma unroll
                for (int d = 32; d >= 1; d >>= 1) ss += __shfl_xor(ss, d);
                const float rstd = rsqrtf(ss * (1.0f / 1024.0f) + 1e-6f);
#pragma unroll
                for (int i = 0; i < 4; ++i) { const f32x4 w = nwv[i]; u32x2 o; o.x = pk2(v[rr][i][0] * rstd * w[0], v[rr][i][1] * rstd * w[1]); o.y = pk2(v[rr][i][2] * rstd * w[2], v[rr][i][3] * rstd * w[3]);
                    *(u32x2*)(xn + (size_t)(row0 + r) * 1024 + lane * 4 + 256 * i) = o; *(u32x2*)(sA + r * 1032 + lane * 4 + 256 * i) = o; } }
        }
        __syncthreads();
        { const int rt = wid >> 1, ct = wid & 1; f32x4 acc = {0.f, 0.f, 0.f, 0.f};
          const bf16_t* ap = sA + (rt * 16 + (lane & 15)) * 1032 + 8 * (lane >> 4); const bf16_t* bp = wsp + (size_t)(ct * 16 + (lane & 15)) * 1024 + 8 * (lane >> 4);
#pragma unroll 8
          for (int ks = 0; ks < 32; ++ks) acc = mfma16(*(const bf16x8*)(ap + ks * 32), *(const bf16x8*)(bp + ks * 32), acc);
#pragma unroll
          for (int j = 0; j < 4; ++j) spec[(size_t)(row0 + rt * 16 + 4 * (lane >> 4) + j) * 32 + ct * 16 + (lane & 15)] = acc[j]; }
        __syncthreads();
    }
}
template <bool CONV, int NCOLS>
__device__ __forceinline__ void load_chunk(bf16_t* dst, int dstride, const bf16_t* proj, int ld, int tok0, int tpos0, int col0, const float* cw, const float* cb, int cwn, int ch0, float scale) {
    constexpr int NGRP = NCOLS / 8, NT = 128 * NGRP / 512, BT = NT < 4 ? NT : 4;
    const int tid = ltid();
    f32x4 wq[4][2];
    if (CONV) { const int cg0 = ch0 + (tid % NGRP) * 8;
#pragma unroll
        for (int k = 0; k < 3; ++k) { wq[k][0] = *(const f32x4*)(cw + k * cwn + cg0); wq[k][1] = *(const f32x4*)(cw + k * cwn + cg0 + 4); }
        wq[3][0] = *(const f32x4*)(cb + cg0); wq[3][1] = *(const f32x4*)(cb + cg0 + 4); }
#pragma unroll 1
    for (int bt = 0; bt < NT / BT; ++bt) {
        u32x4 u0[BT], u1[BT], u2[BT];
#pragma unroll
        for (int i = 0; i < BT; ++i) { const int task = tid + 512 * (bt * BT + i), r = task / NGRP, cgp = task % NGRP;
            const bf16_t* pp = proj + (size_t)(tok0 + r) * ld + col0 + cgp * 8;
            u1[i] = *(const u32x4*)pp;
            if (CONV) { const bool hp = (tpos0 + r > 0), hn = (tpos0 + r < SEQ - 1); u0[i] = *(const u32x4*)(pp - (hp ? ld : 0)); u2[i] = *(const u32x4*)(pp + (hn ? ld : 0)); } }
#pragma unroll
        for (int i = 0; i < BT; ++i) { const int task = tid + 512 * (bt * BT + i), r = task / NGRP, cgp = task % NGRP; float v[8];
            if (CONV) { float x0[8], x1[8], x2[8]; const float mp = (tpos0 + r > 0) ? 1.0f : 0.0f, mn = (tpos0 + r < SEQ - 1) ? 1.0f : 0.0f;
                unpack8(u0[i], x0); unpack8(u1[i], x1); unpack8(u2[i], x2);
#pragma unroll
                for (int e = 0; e < 8; ++e) { x0[e] *= mp; x2[e] *= mn; }
#pragma unroll
                for (int e = 0; e < 8; ++e) { const float t = wq[3][e >> 2][e & 3] + wq[0][e >> 2][e & 3] * x0[e] + wq[1][e >> 2][e & 3] * x1[e] + wq[2][e >> 2][e & 3] * x2[e]; v[e] = silu_f(t) * scale; }
            } else { unpack8(u1[i], v);
#pragma unroll
                for (int e = 0; e < 8; ++e) v[e] *= scale; }
            *(u32x4*)(dst + r * dstride + cgp * 8) = pack8(v); }
    }
}
template <int STRIDE, int KROWS = 32> __device__ __forceinline__ void tr_frags4(bf16x8 (&f)[4], const bf16_t* tile, int col0) {
    const int lane = ltid() & 63, g = lane >> 4, q = (lane & 15) >> 2, pp = lane & 3;
    const unsigned a = (unsigned)(size_t)(tile + (8 * g + q) * STRIDE + col0) + 8u * pp;
    u32x2 r0, r1, r2, r3, r4, r5, r6, r7;
    asm volatile("ds_read_b64_tr_b16 %0, %8 offset:%9\n\tds_read_b64_tr_b16 %1, %8 offset:%10\n\tds_read_b64_tr_b16 %2, %8 offset:%11\n\tds_read_b64_tr_b16 %3, %8 offset:%12\n\t"
                 "ds_read_b64_tr_b16 %4, %8 offset:%13\n\tds_read_b64_tr_b16 %5, %8 offset:%14\n\tds_read_b64_tr_b16 %6, %8 offset:%15\n\tds_read_b64_tr_b16 %7, %8 offset:%16\n\ts_waitcnt lgkmcnt(0)"
                 : "=&v"(r0), "=&v"(r1), "=&v"(r2), "=&v"(r3), "=&v"(r4), "=&v"(r5), "=&v"(r6), "=&v"(r7)
                 : "v"(a), "i"(0 * STRIDE * 2), "i"(4 * STRIDE * 2), "i"(KROWS * STRIDE * 2), "i"((KROWS + 4) * STRIDE * 2), "i"(2 * KROWS * STRIDE * 2), "i"((2 * KROWS + 4) * STRIDE * 2), "i"(3 * KROWS * STRIDE * 2), "i"((3 * KROWS + 4) * STRIDE * 2) : "memory");
    f[0] = as_bf16x8((u32x4){r0.x, r0.y, r1.x, r1.y}); f[1] = as_bf16x8((u32x4){r2.x, r2.y, r3.x, r3.y}); f[2] = as_bf16x8((u32x4){r4.x, r4.y, r5.x, r5.y}); f[3] = as_bf16x8((u32x4){r6.x, r6.y, r7.x, r7.y});
}
__device__ __forceinline__ bf16x8 gather8(const bf16_t* base, int stride) {
    bf16x8 r;
#pragma unroll
    for (int e = 0; e < 8; ++e) r[e] = (short)base[e * stride];
    return r;
}
__device__ __forceinline__ void lds_transpose(const bf16_t* src, int sstride, bf16_t* dst, int ncols) {
    for (int task = ltid(); task < 16 * ncols; task += 512) { const int c = task % ncols, rg = task / ncols; u32x4 w;
        const bf16_t* sp = src + (rg * 8) * sstride + c;
        w.x = (unsigned)sp[0] | ((unsigned)sp[sstride] << 16); w.y = (unsigned)sp[2 * sstride] | ((unsigned)sp[3 * sstride] << 16);
        w.z = (unsigned)sp[4 * sstride] | ((unsigned)sp[5 * sstride] << 16); w.w = (unsigned)sp[6 * sstride] | ((unsigned)sp[7 * sstride] << 16);
        *(u32x4*)(dst + c * 136 + rg * 8) = w; }
}
template <int MODE>
__device__ __forceinline__ void decay_prep(KPR p, int layer, int hdl, int headg, int dir, int tok0, float* sE, float* sWv, float* sWgt, float* sTot) {
    const int lane = ltid() & 63; const float* spec = (const float*)(p.ws + WS_SPEC);
    const int u0 = 2 * lane, u1 = u0 + 1, s0 = dir ? 127 - u0 : u0, s1 = dir ? 127 - u1 : u1;
    float a0, a1, w0, w1;
    if (MODE == 0) {
        const float bias = p.in[I_MBDTB][layer * 16 + dir * 8 + headg], A = -__expf(p.in[I_MBALOG][layer * 16 + dir * 8 + headg]);
        const float r0 = spec[(size_t)(tok0 + s0) * 32 + dir * 8 + headg] + bias, r1 = spec[(size_t)(tok0 + s1) * 32 + dir * 8 + headg] + bias;
        w0 = r0 > 20.f ? r0 : log1pf(__expf(r0)); w1 = r1 > 20.f ? r1 : log1pf(__expf(r1)); a0 = w0 * A; a1 = w1 * A;
    } else {
        const float bi = p.in[I_MLGB][layer * 16 + dir * 8 + headg], bf = p.in[I_MLGB][layer * 16 + dir * 8 + 4 + headg];
        const float i0 = spec[(size_t)(tok0 + s0) * 32 + 16 + dir * 8 + headg] + bi, i1 = spec[(size_t)(tok0 + s1) * 32 + 16 + dir * 8 + headg] + bi;
        const float f0 = spec[(size_t)(tok0 + s0) * 32 + 16 + dir * 8 + 4 + headg] + bf, f1 = spec[(size_t)(tok0 + s1) * 32 + 16 + dir * 8 + 4 + headg] + bf;
        w0 = __expf(i0); w1 = __expf(i1);
        a0 = fminf(f0, 0.f) - log1pf(__expf(-fabsf(f0))); a1 = fminf(f1, 0.f) - log1pf(__expf(-fabsf(f1)));
    }
    const float pr = a0 + a1; float incl = pr;
#pragma unroll
    for (int d = 1; d < 64; d <<= 1) { const float t = __shfl_up(incl, d); if (lane >= d) incl += t; }
    const float e0 = incl - pr + a0, e1 = incl, tot = __shfl(incl, 63);
    sE[hdl * 128 + s0] = e0; sE[hdl * 128 + s1] = e1; sWv[hdl * 128 + s0] = w0; sWv[hdl * 128 + s1] = w1;
    if (sWgt) { sWgt[hdl * 128 + s0] = __expf(tot - e0) * w0; sWgt[hdl * 128 + s1] = __expf(tot - e1) * w1; if (lane == 0) sTot[hdl] = tot; }
}

template <int MODE> struct SsdCfg;
template <> struct SsdCfg<0> { static constexpr int NH = 4, PT = 4, PP = 64, NHT = 8, LD = 1536, NITEM = 512, PTO = 4; };
template <> struct SsdCfg<1> { static constexpr int NH = 1, PT = 9, PP = 144, NHT = 4, LD = 2560, NITEM = 1024, PTO = 8; };

template <int MODE>
__device__ __forceinline__ void ssd_m1(KPR p, int layer, unsigned char* smem) {
    typedef SsdCfg<MODE> C;
    constexpr int XS = (MODE == 0) ? 264 : 152;
    bf16_t* sBm = (bf16_t*)smem; bf16_t* sX = sBm + 128 * 136;
    float* sE = (float*)(smem + 34816 + 67584); float* sWv = sE + 1024; float* sWgt = sWv + 1024; float* sTot = sWgt + 1024;
    const bf16_t* proj = (const bf16_t*)(p.ws + WS_PROJ); bf16_t* ST = (bf16_t*)(p.ws + WS_AUX); float* atot = (float*)(p.ws + WS_ATOT);
    const int tid = ltid(), wid = tid >> 6, lane = tid & 63, lr = lane & 15, lq = lane >> 4;
    const float* cw = p.in[MODE == 0 ? I_MBCW : I_MLCW] + layer * 3 * 1024; const float* cb = p.in[MODE == 0 ? I_MBCB : I_MLCB] + layer * 1024;
    for (int it = blockIdx.x; it < C::NITEM; it += gridDim.x) {
        int g, c, b;
        if (MODE == 0) { g = it & 1; c = (it >> 1) & 63; b = it >> 7; } else { g = it & 3; c = (it >> 2) & 63; b = it >> 8; }
        const int tok0 = b * SEQ + c * 128, tpos0 = c * 128;
        load_chunk<true, 128>(sBm, 136, proj, C::LD, tok0, tpos0, 512 + g * 128, cw, cb, 1024, 512 + g * 128, MODE == 0 ? 1.0f : 0.08838834764831845f);
        if (MODE == 0) { load_chunk<true, 128>(sX, XS, proj, C::LD, tok0, tpos0, g * 256, cw, cb, 1024, g * 256, 1.0f); load_chunk<true, 128>(sX + 128, XS, proj, C::LD, tok0, tpos0, g * 256 + 128, cw, cb, 1024, g * 256 + 128, 1.0f); }
        else { load_chunk<false, 128>(sX, XS, proj, C::LD, tok0, tpos0, 1024 + g * 128, cw, cb, 1024, 0, 1.0f);
            for (int idx = tid; idx < 128 * 16; idx += 512) sX[(idx >> 4) * XS + 128 + (idx & 15)] = ((idx & 15) == 0) ? (bf16_t)0x3F80 : (bf16_t)0; }
        if (wid < 2 * C::NH) { const int hl = wid >> 1, dir = wid & 1, headg = (MODE == 0) ? g * 4 + hl : g; decay_prep<MODE>(p, layer, wid, headg, dir, tok0, sE, sWv, sWgt, sTot); }
        __syncthreads();
        for (int t = wid; t < C::NH * 2 * C::PT; t += 8) {
            const int hdl = t % (2 * C::NH), pt = t / (2 * C::NH), hl = hdl >> 1, dir = hdl & 1, headg = (MODE == 0) ? g * 4 + hl : g;
            bf16x8 bfr[4]; tr_frags4<XS>(bfr, sX, hl * C::PP + pt * 16);
#pragma unroll
            for (int ks = 0; ks < 4; ++ks) { const int sb = ks * 32 + 8 * lq; float v[8]; union { bf16x8 b; u32x4 u; } cv; cv.b = bfr[ks]; unpack8(cv.u, v);
                const f32x4 w0 = *(const f32x4*)(sWgt + hdl * 128 + sb), w1 = *(const f32x4*)(sWgt + hdl * 128 + sb + 4);
                v[0] *= w0[0]; v[1] *= w0[1]; v[2] *= w0[2]; v[3] *= w0[3]; v[4] *= w1[0]; v[5] *= w1[1]; v[6] *= w1[2]; v[7] *= w1[3];
                bfr[ks] = as_bf16x8(pack8(v)); }
            const int seq = (b * C::NHT + headg) * 2 + dir;
            bf16_t* outp = ST + (size_t)(seq * 64 + c) * C::PP * 128;
#pragma unroll
            for (int nt = 0; nt < 8; ++nt) { f32x4 acc = {0.f, 0.f, 0.f, 0.f}; bf16x8 af[4]; tr_frags4<136>(af, sBm, nt * 16);
#pragma unroll
                for (int ks = 0; ks < 4; ++ks) acc = mfma16(af[ks], bfr[ks], acc);
                u32x2 o; o.x = pk2(acc[0], acc[1]); o.y = pk2(acc[2], acc[3]);
                *(u32x2*)(outp + (pt * 16 + lr) * 128 + nt * 16 + 4 * lq) = o; }
        }
        if (tid < 2 * C::NH) { const int hl = tid >> 1, dir = tid & 1, headg = (MODE == 0) ? g * 4 + hl : g; atot[((b * C::NHT + headg) * 2 + dir) * 64 + c] = sTot[tid]; }
        __syncthreads();
    }
}
template <int MODE>
__device__ __forceinline__ void ssd_m2(KPR p) {
    typedef SsdCfg<MODE> C;
    bf16_t* ST = (bf16_t*)(p.ws + WS_AUX); const float* atot = (const float*)(p.ws + WS_ATOT);
    constexpr int PER = C::PP * 128 / 4, NSEQ = 4 * C::NHT * 2, TOTAL = NSEQ * PER;
    for (int task = blockIdx.x * 512 + ltid(); task < TOTAL; task += gridDim.x * 512) {
        const int seq = task / PER, off = (task % PER) * 4, dir = seq & 1;
        float h0 = 0.f, h1 = 0.f, h2 = 0.f, h3 = 0.f;
#pragma unroll 1
        for (int cb = 0; cb < 64; cb += 16) {
            u32x2 sv[16]; float dv[16];
#pragma unroll
            for (int i = 0; i < 16; ++i) { const int c = dir ? 63 - (cb + i) : (cb + i); sv[i] = *(const u32x2*)(ST + (size_t)(seq * 64 + c) * C::PP * 128 + off); dv[i] = atot[seq * 64 + c]; }
#pragma unroll
            for (int i = 0; i < 16; ++i) { const int c = dir ? 63 - (cb + i) : (cb + i); const float d = __expf(dv[i]);
                u32x2 o; o.x = pk2(h0, h1); o.y = pk2(h2, h3); *(u32x2*)(ST + (size_t)(seq * 64 + c) * C::PP * 128 + off) = o;
                h0 = h0 * d + __uint_as_float(sv[i].x << 16); h1 = h1 * d + __uint_as_float(sv[i].x & 0xffff0000u);
                h2 = h2 * d + __uint_as_float(sv[i].y << 16); h3 = h3 * d + __uint_as_float(sv[i].y & 0xffff0000u); }
        }
    }
}
template <int MODE>
__device__ __forceinline__ void ssd_m3(KPR p, int layer, unsigned char* smem) {
    typedef SsdCfg<MODE> C;
    constexpr int XS = (MODE == 0) ? 72 : 152;
    bf16_t* sC = (bf16_t*)smem; bf16_t* sB = (bf16_t*)(smem + 34816); bf16_t* sXT = (bf16_t*)(smem + 73984); bf16_t* sG = (bf16_t*)(smem + 113152);
    float* sE = (float*)(smem + 147968); float* sWv = sE + 1024;
    const bf16_t* proj = (const bf16_t*)(p.ws + WS_PROJ); const bf16_t* ST = (const bf16_t*)(p.ws + WS_AUX); bf16_t* Y = (bf16_t*)(p.ws + WS_Y);
    const int tid = ltid(), wid = tid >> 6, lane = tid & 63, lr = lane & 15, lq = lane >> 4;
    const float* cw = p.in[MODE == 0 ? I_MBCW : I_MLCW] + layer * 3 * 1024; const float* cb = p.in[MODE == 0 ? I_MBCB : I_MLCB] + layer * 1024;
    for (int it = blockIdx.x; it < C::NITEM; it += gridDim.x) {
        int g, c, b;
        if (MODE == 0) { g = it & 1; c = (it >> 1) & 63; b = it >> 7; } else { g = it & 3; c = (it >> 2) & 63; b = it >> 8; }
        const int tok0 = b * SEQ + c * 128, tpos0 = c * 128;
        if (MODE == 0) {
            load_chunk<true, 128>(sC, 136, proj, C::LD, tok0, tpos0, 768 + g * 128, cw, cb, 1024, 768 + g * 128, 1.0f);
            load_chunk<true, 128>(sB, 136, proj, C::LD, tok0, tpos0, 512 + g * 128, cw, cb, 1024, 512 + g * 128, 1.0f);
        } else {
            load_chunk<true, 128>(sC, 136, proj, C::LD, tok0, tpos0, g * 128, cw, cb, 1024, g * 128, 1.0f);
            load_chunk<true, 128>(sB, 136, proj, C::LD, tok0, tpos0, 512 + g * 128, cw, cb, 1024, 512 + g * 128, 0.08838834764831845f);
        }
        if (MODE == 1) { load_chunk<false, 128>(sG, 136, proj, C::LD, tok0, tpos0, 1024 + g * 128, cw, cb, 1024, 0, 1.0f);
            for (int idx = tid; idx < 16 * 128; idx += 512) sXT[(128 + (idx >> 7)) * 136 + (idx & 127)] = (idx < 128) ? (bf16_t)0x3F80 : (bf16_t)0; }
        if (wid < 2 * C::NH) { const int hl = wid >> 1, dir = wid & 1, headg = (MODE == 0) ? g * 4 + hl : g; decay_prep<MODE>(p, layer, wid, headg, dir, tok0, sE, sWv, nullptr, nullptr); }
        __syncthreads();
        if (MODE == 1) lds_transpose(sG, 136, sXT, 128);
        f32x4 accG[8];
#pragma unroll
        for (int st = 0; st < 8; ++st) { accG[st] = (f32x4){0.f, 0.f, 0.f, 0.f};
#pragma unroll
            for (int ks = 0; ks < 4; ++ks) accG[st] = mfma16(*(const bf16x8*)(sC + (16 * wid + lr) * 136 + ks * 32 + 8 * lq), *(const bf16x8*)(sB + (st * 16 + lr) * 136 + ks * 32 + 8 * lq), accG[st]); }
        __syncthreads();
        f32x4 outv[C::PTO]; float ssr[4] = {0.f, 0.f, 0.f, 0.f};
#pragma unroll 1
        for (int hl = 0; hl < C::NH; ++hl) {
            const int headg = (MODE == 0) ? g * 4 + hl : g;
#pragma unroll
            for (int i = 0; i < C::PTO; ++i) outv[i] = (f32x4){0.f, 0.f, 0.f, 0.f};
            if (MODE == 0) { load_chunk<true, 64>(sG, 72, proj, C::LD, tok0, tpos0, headg * 64, cw, cb, 1024, headg * 64, 1.0f); __syncthreads(); lds_transpose(sG, 72, sXT, 64); __syncthreads(); }

#pragma unroll 1
            for (int dir = 0; dir < 2; ++dir) {
                const int hdl = hl * 2 + dir, seq = (b * C::NHT + headg) * 2 + dir;
                const bf16_t* Hs = ST + (size_t)(seq * 64 + c) * C::PP * 128;
                { constexpr int NHT_T = (C::PP * 16 + 511) / 512; u32x4 hv[NHT_T];
#pragma unroll
                  for (int i = 0; i < NHT_T; ++i) { const int task = tid + 512 * i, tk = task < C::PP * 16 ? task : 0; hv[i] = *(const u32x4*)(Hs + (tk >> 4) * 128 + (tk & 15) * 8); }
#pragma unroll
                  for (int i = 0; i < NHT_T; ++i) { const int task = tid + 512 * i; if (task < C::PP * 16) *(u32x4*)(sB + (task >> 4) * 136 + (task & 15) * 8) = hv[i]; } }
                float et[4];
#pragma unroll
                for (int j = 0; j < 4; ++j) et[j] = sE[hdl * 128 + 16 * wid + 4 * lq + j];
#pragma unroll
                for (int st = 0; st < 8; ++st) { const int s = st * 16 + lr; const float es = sE[hdl * 128 + s], ws = sWv[hdl * 128 + s];
#pragma unroll
                    for (int j = 0; j < 4; ++j) { const int t = 16 * wid + 4 * lq + j; const bool valid = dir ? (s >= t) : (s <= t);
                        const float val = valid ? accG[st][j] * __expf(fminf(et[j] - es, 0.f)) * ws : 0.f; sG[t * 136 + s] = f2bf(val); } }
                __syncthreads();
                f32x4 acc[C::PT];
#pragma unroll
                for (int pt = 0; pt < C::PT; ++pt) acc[pt] = (f32x4){0.f, 0.f, 0.f, 0.f};
#pragma unroll
                for (int ks = 0; ks < 4; ++ks) { const bf16x8 a2 = *(const bf16x8*)(sC + (16 * wid + lr) * 136 + ks * 32 + 8 * lq);
#pragma unroll
                    for (int pt = 0; pt < C::PT; ++pt) acc[pt] = mfma16(a2, *(const bf16x8*)(sB + (pt * 16 + lr) * 136 + ks * 32 + 8 * lq), acc[pt]); }
#pragma unroll
                for (int j = 0; j < 4; ++j) { const float ex = __expf(et[j]);
#pragma unroll
                    for (int pt = 0; pt < C::PT; ++pt) acc[pt][j] *= ex; }
#pragma unroll
                for (int ks = 0; ks < 4; ++ks) { const bf16x8 a = *(const bf16x8*)(sG + (16 * wid + lr) * 136 + ks * 32 + 8 * lq);
#pragma unroll
                    for (int pt = 0; pt < C::PT; ++pt) acc[pt] = mfma16(a, *(const bf16x8*)(sXT + (pt * 16 + lr) * 136 + ks * 32 + 8 * lq), acc[pt]); }
#pragma unroll
                for (int j = 0; j < 4; ++j) {
                    if (MODE == 0) {
#pragma unroll
                        for (int pt = 0; pt < 4; ++pt) outv[pt][j] += acc[pt][j];
                    } else {
                        float den = acc[C::PT - 1][j]; den = __shfl(den, lane & 48); const float inv = rcp_f(fmaxf(fabsf(den), 1.0f));
#pragma unroll
                        for (int pt = 0; pt < 8; ++pt) outv[pt][j] += acc[pt][j] * inv;
                    } }
                __syncthreads();
            }
            if (MODE == 0) { const float D = p.in[I_MBD][layer * 8 + headg];
#pragma unroll
                for (int pt = 0; pt < 4; ++pt)
#pragma unroll
                    for (int j = 0; j < 4; ++j) outv[pt][j] += D * bf2f(sXT[(pt * 16 + lr) * 136 + 16 * wid + 4 * lq + j]);
#pragma unroll
                for (int j = 0; j < 4; ++j) { const size_t tok = (size_t)tok0 + 16 * wid + 4 * lq + j;
#pragma unroll
                    for (int pt = 0; pt < 4; ++pt) { const int col = hl * 64 + pt * 16 + lr; const float z = bf2f(proj[tok * 1536 + 1024 + g * 256 + col]); const float v = outv[pt][j] * silu_f(z);
                        ssr[j] += v * v; Y[tok * 2048 + 512 + g * 256 + col] = f2bf(v); } }
                __syncthreads(); }
        }
        if (MODE == 0) {
            float* sR = sE;
#pragma unroll
            for (int j = 0; j < 4; ++j) { float ss = ssr[j];
#pragma unroll
                for (int d = 1; d < 16; d <<= 1) ss += __shfl_xor(ss, d);
                if (lr == 0) sR[16 * wid + 4 * lq + j] = rsqrtf(ss * (1.0f / 256.0f) + 1e-6f); }
            __syncthreads();
            for (int task = tid; task < 128 * 32; task += 512) { const int r = task >> 5, cgp = task & 31; bf16_t* yp = Y + ((size_t)tok0 + r) * 2048 + 512 + g * 256 + cgp * 8;
                float v[8]; unpack8(*(const u32x4*)yp, v); const float rstd = sR[r]; const float* nw = p.in[I_MBNW] + layer * 512 + g * 256 + cgp * 8;
#pragma unroll
                for (int e = 0; e < 8; ++e) v[e] *= rstd * nw[e];
                *(u32x4*)yp = pack8(v); }
        } else {
            float* sH = (float*)smem;
#pragma unroll
            for (int i = 0; i < 8; ++i)
#pragma unroll
                for (int j = 0; j < 4; ++j) sH[(16 * wid + 4 * lq + j) * 132 + i * 16 + lr] = outv[i][j];
            asm volatile("s_waitcnt lgkmcnt(0)" ::: "memory");
            { u32x4 ou[4], zu[4];
#pragma unroll
              for (int i = 0; i < 4; ++i) { const int task = lane + 64 * i, row = 16 * wid + (task >> 4), cgp = task & 15; const bf16_t* pp = proj + ((size_t)tok0 + row) * 2560 + 1536 + g * 128 + cgp * 8;
                  ou[i] = *(const u32x4*)pp; zu[i] = *(const u32x4*)(pp + 512); }
              const f32x4 nw0 = *(const f32x4*)(p.in[I_MLNW] + layer * 512 + g * 128 + (lane & 15) * 8), nw1 = *(const f32x4*)(p.in[I_MLNW] + layer * 512 + g * 128 + (lane & 15) * 8 + 4);
#pragma unroll
              for (int i = 0; i < 4; ++i) { const int task = lane + 64 * i, row = 16 * wid + (task >> 4), cgp = task & 15; float o[8], z[8], v[8]; unpack8(ou[i], o); unpack8(zu[i], z);
                  const f32x4 h0 = *(const f32x4*)(sH + row * 132 + cgp * 8), h1 = *(const f32x4*)(sH + row * 132 + cgp * 8 + 4); float ss = 0.f;
#pragma unroll
                  for (int e = 0; e < 8; ++e) { v[e] = (e < 4 ? h0[e] : h1[e - 4]) * sigmoid_f(o[e]); ss += v[e] * v[e]; }
#pragma unroll
                  for (int d = 1; d < 16; d <<= 1) ss += __shfl_xor(ss, d);
                  const float rstd = rsqrtf(ss * (1.0f / 128.0f) + 1e-6f);
#pragma unroll
                  for (int e = 0; e < 8; ++e) v[e] *= rstd * (e < 4 ? nw0[e] : nw1[e - 4]) * silu_f(z[e]);
                  *(u32x4*)(Y + ((size_t)tok0 + row) * 2048 + 1024 + g * 128 + cgp * 8) = pack8(v); } }
        }
        __syncthreads();
    }
}
__device__ __forceinline__ void ssd_m3_mamba(KPR p, int layer, unsigned char* smem) {
    bf16_t* sC = (bf16_t*)smem; bf16_t* sB = (bf16_t*)(smem + 34816); bf16_t* sXT = (bf16_t*)(smem + 73984); bf16_t* sG = (bf16_t*)(smem + 113152);
    float* sE = (float*)(smem + 147968); float* sWv = sE + 1024;
    const bf16_t* proj = (const bf16_t*)(p.ws + WS_PROJ); const bf16_t* ST = (const bf16_t*)(p.ws + WS_AUX); bf16_t* Y = (bf16_t*)(p.ws + WS_Y);
    const int tid = ltid(), wid = tid >> 6, lane = tid & 63, lr = lane & 15, lq = lane >> 4;
    const float* cw = p.in[I_MBCW] + layer * 3 * 1024; const float* cb = p.in[I_MBCB] + layer * 1024;
    for (int it = blockIdx.x; it < 512; it += gridDim.x) {
        const int g = it & 1, c = (it >> 1) & 63, b = it >> 7, tok0 = b * SEQ + c * 128, tpos0 = c * 128;
        load_chunk<true, 128>(sC, 136, proj, 1536, tok0, tpos0, 768 + g * 128, cw, cb, 1024, 768 + g * 128, 1.0f);
        load_chunk<true, 128>(sB, 136, proj, 1536, tok0, tpos0, 512 + g * 128, cw, cb, 1024, 512 + g * 128, 1.0f);
        { const int hl = wid >> 1, dir = wid & 1; decay_prep<0>(p, layer, wid, g * 4 + hl, dir, tok0, sE, sWv, nullptr, nullptr); }
        __syncthreads();
        f32x4 accG[8];
#pragma unroll
        for (int st = 0; st < 8; ++st) { accG[st] = (f32x4){0.f, 0.f, 0.f, 0.f};
#pragma unroll
            for (int ks = 0; ks < 4; ++ks) accG[st] = mfma16(*(const bf16x8*)(sC + (16 * wid + lr) * 136 + ks * 32 + 8 * lq), *(const bf16x8*)(sB + (st * 16 + lr) * 136 + ks * 32 + 8 * lq), accG[st]); }
        __syncthreads();
        float ssr[4] = {0.f, 0.f, 0.f, 0.f};
#pragma unroll 1
        for (int hl = 0; hl < 4; ++hl) {
            const int headg = g * 4 + hl;
            load_chunk<true, 64>(sG, 72, proj, 1536, tok0, tpos0, headg * 64, cw, cb, 1024, headg * 64, 1.0f);
            { const bf16_t* Hf = ST + (size_t)(((b * 8 + headg) * 2) * 64 + c) * 8192; const bf16_t* Hb = ST + (size_t)(((b * 8 + headg) * 2 + 1) * 64 + c) * 8192;
              u32x4 hv[4];
#pragma unroll
              for (int i = 0; i < 4; ++i) { const int task = tid + 512 * i, row = task >> 4, cgp = task & 15; const bf16_t* src = (row < 64) ? (Hf + row * 128) : (Hb + (row - 64) * 128); hv[i] = *(const u32x4*)(src + cgp * 8); }
              load_chunk<true, 64>(sXT, 72, proj, 1536, tok0, tpos0, headg * 64, cw, cb, 1024, headg * 64, 1.0f);
#pragma unroll
              for (int i = 0; i < 4; ++i) { const int task = tid + 512 * i; *(u32x4*)(sB + (task >> 4) * 136 + (task & 15) * 8) = hv[i]; } }
            float etf[4], etb[4];
#pragma unroll
            for (int j = 0; j < 4; ++j) { etf[j] = sE[(hl * 2) * 128 + 16 * wid + 4 * lq + j]; etb[j] = sE[(hl * 2 + 1) * 128 + 16 * wid + 4 * lq + j]; }
#pragma unroll
            for (int st = 0; st < 8; ++st) { const int s = st * 16 + lr; const float esf = sE[(hl * 2) * 128 + s], wsf = sWv[(hl * 2) * 128 + s], esb = sE[(hl * 2 + 1) * 128 + s], wsb = sWv[(hl * 2 + 1) * 128 + s];
#pragma unroll
                for (int j = 0; j < 4; ++j) { const int t = 16 * wid + 4 * lq + j;
                    const float df = (s <= t) ? __expf(fminf(etf[j] - esf, 0.f)) * wsf : 0.f, db = (s >= t) ? __expf(fminf(etb[j] - esb, 0.f)) * wsb : 0.f;
                    sG[t * 136 + s] = f2bf(accG[st][j] * (df + db)); } }
            __syncthreads();
            f32x4 accd[4], accf[4], accb[4];
#pragma unroll
            for (int pt = 0; pt < 4; ++pt) { accd[pt] = (f32x4){0.f, 0.f, 0.f, 0.f}; accf[pt] = accd[pt]; accb[pt] = accd[pt]; }
            { bf16x8 ag[4], ac[4];
#pragma unroll
              for (int ks = 0; ks < 4; ++ks) { ag[ks] = *(const bf16x8*)(sG + (16 * wid + lr) * 136 + ks * 32 + 8 * lq); ac[ks] = *(const bf16x8*)(sC + (16 * wid + lr) * 136 + ks * 32 + 8 * lq); }
#pragma unroll
              for (int pt = 0; pt < 4; ++pt) { bf16x8 xb[4]; tr_frags4<72>(xb, sXT, pt * 16);
#pragma unroll
                  for (int ks = 0; ks < 4; ++ks) { accd[pt] = mfma16(ag[ks], xb[ks], accd[pt]);
                      accf[pt] = mfma16(ac[ks], *(const bf16x8*)(sB + (pt * 16 + lr) * 136 + ks * 32 + 8 * lq), accf[pt]);
                      accb[pt] = mfma16(ac[ks], *(const bf16x8*)(sB + (64 + pt * 16 + lr) * 136 + ks * 32 + 8 * lq), accb[pt]); } } }
            const float D = p.in[I_MBD][layer * 8 + headg];
            bf16_t zraw[4][4];
#pragma unroll
            for (int pt = 0; pt < 4; ++pt)
#pragma unroll
                for (int j = 0; j < 4; ++j) zraw[pt][j] = proj[((size_t)tok0 + 16 * wid + 4 * lq + j) * 1536 + 1024 + g * 256 + hl * 64 + pt * 16 + lr];
#pragma unroll
            for (int pt = 0; pt < 4; ++pt) { float xv[4];
#pragma unroll
                for (int j = 0; j < 4; ++j) xv[j] = bf2f(sXT[(16 * wid + 4 * lq + j) * 72 + pt * 16 + lr]);
#pragma unroll
                for (int j = 0; j < 4; ++j) { const size_t tok = (size_t)tok0 + 16 * wid + 4 * lq + j; const int col = hl * 64 + pt * 16 + lr;
                    const float yv = accd[pt][j] + __expf(etf[j]) * accf[pt][j] + __expf(etb[j]) * accb[pt][j] + D * xv[j];
                    const float z = bf2f(zraw[pt][j]); const float v = yv * silu_f(z);
                    ssr[j] += v * v; Y[tok * 2048 + 512 + g * 256 + col] = f2bf(v); } }
            __syncthreads();
        }
        float* sR = sE;
#pragma unroll
        for (int j = 0; j < 4; ++j) { float ss = ssr[j];
#pragma unroll
            for (int d = 1; d < 16; d <<= 1) ss += __shfl_xor(ss, d);
            if (lr == 0) sR[16 * wid + 4 * lq + j] = rsqrtf(ss * (1.0f / 256.0f) + 1e-6f); }
        __syncthreads();
#pragma unroll 1
        for (int bt = 0; bt < 2; ++bt) { u32x4 yv[4];
#pragma unroll
            for (int i = 0; i < 4; ++i) { const int task = tid + 512 * (bt * 4 + i), r = task >> 5, cgp = task & 31; yv[i] = *(const u32x4*)(Y + ((size_t)tok0 + r) * 2048 + 512 + g * 256 + cgp * 8); }
#pragma unroll
            for (int i = 0; i < 4; ++i) { const int task = tid + 512 * (bt * 4 + i), r = task >> 5, cgp = task & 31; float v[8]; unpack8(yv[i], v); const float rstd = sR[r]; const float* nw = p.in[I_MBNW] + layer * 512 + g * 256 + cgp * 8;
#pragma unroll
                for (int e = 0; e < 8; ++e) v[e] *= rstd * nw[e];
                *(u32x4*)(Y + ((size_t)tok0 + r) * 2048 + 512 + g * 256 + cgp * 8) = pack8(v); } }
        __syncthreads();
    }
}
__device__ __forceinline__ void na_phase(KPR p, int layer, unsigned char* smem) {
    bf16_t* sV = (bf16_t*)smem;
    bf16_t* sP = (bf16_t*)(smem + 82944);
    float* sRpb = (float*)(smem + 82944 + 67584);
    const bf16_t* proj = (const bf16_t*)(p.ws + WS_PROJ); bf16_t* Y = (bf16_t*)(p.ws + WS_Y);
    const float* qnw = p.in[I_NAQN] + layer * 64; const float* knw = p.in[I_NAKN] + layer * 64; const float* rpb = p.in[I_NARPB] + layer * 8 * 15 * 31;
    const int tid = ltid(), wid = tid >> 6, lane = tid & 63, lr = lane & 15, lq = lane >> 4;
    bf16_t* sPw = sP + wid * 16 * 264;
    for (int it = blockIdx.x; it < 2048; it += gridDim.x) {
        const int h = it & 7, rp = (it >> 3) & 63, b = it >> 9, r0 = 2 * rp, base = clampi(r0 - 4, 0, 120);
        const int r = r0 + (wid >> 2), qt = wid & 3, rs = clampi(r - 4, 0, 120), cbase = clampi(16 * qt - 8, 0, 32);
        u32x4 ka0[4], ka1[4], uq0, uq1;
        auto load_kgroup = [&](u32x4 (&k0)[4], u32x4 (&k1)[4], int kg) {
#pragma unroll
            for (int kk = 0; kk < 4; ++kk) { const int kt = kg * 4 + kk, i = kt >> 1, cc0 = (kt & 1) * 16, kc = cbase + cc0 + lr, kr = rs + i;
                const bf16_t* kp = proj + (size_t)(b * SEQ + kr * 64 + kc) * 2048 + 512 + h * 64 + 8 * lq; k0[kk] = *(const u32x4*)kp; k1[kk] = *(const u32x4*)(kp + 32); } };
        { u32x4 vv[9];
#pragma unroll
          for (int i = 0; i < 9; ++i) { const int task = tid + 512 * i, kk = task >> 3, dg = task & 7; int row = base + (kk >> 6); row = row < 128 ? row : 127;
              vv[i] = *(const u32x4*)(proj + (size_t)(b * SEQ + row * 64 + (kk & 63)) * 2048 + 1024 + h * 64 + dg * 8); }
          { const bf16_t* qp = proj + (size_t)(b * SEQ + r * 64 + 16 * qt + lr) * 2048 + h * 64 + 8 * lq; uq0 = *(const u32x4*)qp; uq1 = *(const u32x4*)(qp + 32); }
          load_kgroup(ka0, ka1, 0);
#pragma unroll
          for (int i = 0; i < 9; ++i) { const int task = tid + 512 * i, kk = task >> 3, dg = task & 7; *(u32x4*)(sV + kk * 72 + dg * 8) = vv[i]; } }
        if (tid < 465) sRpb[tid] = rpb[h * 465 + tid];
        __syncthreads();
        u32x4 kb0[4], kb1[4]; load_kgroup(kb0, kb1, 1);
        bf16x8 qf[2];
        { float v0[8], v1[8]; unpack8(uq0, v0); unpack8(uq1, v1);
          float ss = 0.f;
#pragma unroll
          for (int e = 0; e < 8; ++e) ss += v0[e] * v0[e] + v1[e] * v1[e];
          ss += __shfl_xor(ss, 16); ss += __shfl_xor(ss, 32); const float rstd = rsqrtf(ss * (1.0f / 64.0f) + 1e-6f) * 0.125f;
#pragma unroll
          for (int e = 0; e < 8; ++e) { v0[e] *= rstd * qnw[8 * lq + e] * knw[8 * lq + e]; v1[e] *= rstd * qnw[32 + 8 * lq + e] * knw[32 + 8 * lq + e]; }
          qf[0] = as_bf16x8(pack8(v0)); qf[1] = as_bf16x8(pack8(v1)); }
        f32x4 S[16];
        bool vld[2][4]; int bof[2][4];
#pragma unroll
        for (int par = 0; par < 2; ++par)
#pragma unroll
            for (int j = 0; j < 4; ++j) { const int cq = 16 * qt + 4 * lq + j, st = clampi(cq - 8, 0, 48), kc = cbase + par * 16 + lr; vld[par][j] = (kc >= st) && (kc < st + 16);
                bof[par][j] = vld[par][j] ? (rs - r + 7) * 31 + (kc - cq + 15) : 0; }
        auto score_kgroup = [&](const u32x4 (&k0)[4], const u32x4 (&k1)[4], int kg) {
#pragma unroll
            for (int kk = 0; kk < 4; ++kk) { const int kt = kg * 4 + kk, i = kt >> 1, par = kt & 1;
                float v0[8], v1[8]; unpack8(k0[kk], v0); unpack8(k1[kk], v1); float ss = 0.f;
#pragma unroll
                for (int e = 0; e < 8; ++e) ss += v0[e] * v0[e] + v1[e] * v1[e];
                ss += __shfl_xor(ss, 16); ss += __shfl_xor(ss, 32); const float rstd = rsqrtf(ss * (1.0f / 64.0f) + 1e-6f);
                f32x4 acc = {0.f, 0.f, 0.f, 0.f}; acc = mfma16(qf[0], as_bf16x8(k0[kk]), acc); acc = mfma16(qf[1], as_bf16x8(k1[kk]), acc);
#pragma unroll
                for (int j = 0; j < 4; ++j) S[kt][j] = vld[par][j] ? acc[j] * rstd + sRpb[bof[par][j] + 31 * i] : -1e30f; } };
        score_kgroup(ka0, ka1, 0); load_kgroup(ka0, ka1, 2);
        score_kgroup(kb0, kb1, 1); load_kgroup(kb0, kb1, 3);
        score_kgroup(ka0, ka1, 2);
        score_kgroup(kb0, kb1, 3);
        float inv[4];
#pragma unroll
        for (int j = 0; j < 4; ++j) { float m = S[0][j];
#pragma unroll
            for (int kt = 1; kt < 16; ++kt) m = fmaxf(m, S[kt][j]);
#pragma unroll
            for (int d = 1; d < 16; d <<= 1) m = fmaxf(m, __shfl_xor(m, d));
            float sum = 0.f;
#pragma unroll
            for (int kt = 0; kt < 16; ++kt) { const float e = __expf(S[kt][j] - m); S[kt][j] = e; sum += e; }
#pragma unroll
            for (int d = 1; d < 16; d <<= 1) sum += __shfl_xor(sum, d);
            inv[j] = rcp_f(sum); }
#pragma unroll
        for (int kt = 0; kt < 16; ++kt)
#pragma unroll
            for (int j = 0; j < 4; ++j) sPw[(4 * lq + j) * 264 + kt * 16 + lr] = f2bf(S[kt][j]);
        asm volatile("s_waitcnt lgkmcnt(0)" ::: "memory");
        f32x4 O[4];
#pragma unroll
        for (int dt = 0; dt < 4; ++dt) O[dt] = (f32x4){0.f, 0.f, 0.f, 0.f};
        {
          const bf16_t* vt = sV + ((rs - base) * 64 + cbase) * 72;
#pragma unroll
          for (int dt = 0; dt < 4; ++dt) { bf16x8 v0[4], v1[4]; tr_frags4<72, 64>(v0, vt, dt * 16); tr_frags4<72, 64>(v1, vt + 4 * 64 * 72, dt * 16);
#pragma unroll
              for (int ks = 0; ks < 4; ++ks) { O[dt] = mfma16(*(const bf16x8*)(sPw + lr * 264 + ks * 32 + 8 * lq), v0[ks], O[dt]); O[dt] = mfma16(*(const bf16x8*)(sPw + lr * 264 + (ks + 4) * 32 + 8 * lq), v1[ks], O[dt]); } } }
        asm volatile("s_waitcnt lgkmcnt(0)" ::: "memory");
        { float* sO = (float*)sPw;
#pragma unroll
          for (int dt = 0; dt < 4; ++dt)
#pragma unroll
              for (int j = 0; j < 4; ++j) sO[(4 * lq + j) * 68 + dt * 16 + lr] = O[dt][j] * inv[j];
          asm volatile("s_waitcnt lgkmcnt(0)" ::: "memory");
          u32x4 gu[2];
#pragma unroll
          for (int i = 0; i < 2; ++i) { const int task = lane + 64 * i, q = task >> 3, cgp = task & 7; gu[i] = *(const u32x4*)(proj + ((size_t)b * SEQ + r * 64 + 16 * qt + q) * 2048 + 1536 + h * 64 + cgp * 8); }
#pragma unroll
          for (int i = 0; i < 2; ++i) { const int task = lane + 64 * i, q = task >> 3, cgp = task & 7; float gv[8], v[8]; unpack8(gu[i], gv);
              const f32x4 o0 = *(const f32x4*)(sO + q * 68 + cgp * 8), o1 = *(const f32x4*)(sO + q * 68 + cgp * 8 + 4);
#pragma unroll
              for (int e = 0; e < 8; ++e) v[e] = (e < 4 ? o0[e] : o1[e - 4]) * silu_f(gv[e]);
              *(u32x4*)(Y + ((size_t)b * SEQ + r * 64 + 16 * qt + q) * 2048 + 1536 + h * 64 + cgp * 8) = pack8(v); } }
        __syncthreads();
    }
}

__device__ __forceinline__ void hy_prep(KPR p, int layer, unsigned char* smem) {
    bf16_t* tile = (bf16_t*)smem;
    const bf16_t* proj = (const bf16_t*)(p.ws + WS_PROJ); bf16_t* hyT = (bf16_t*)(p.ws + WS_AUX);
    const float* cw = p.in[I_HYCW] + layer * 3 * 1536; const float* cb = p.in[I_HYCB] + layer * 1536;
    const int tid = ltid();
    for (int it = blockIdx.x; it < 24 * 64; it += gridDim.x) {
        const int ct = it % 24, tt = it / 24, b = tt >> 4, t0 = (tt & 15) * 512, c0 = ct * 64, cgp = tid & 7;
        float wv[4][8];
#pragma unroll
        for (int e = 0; e < 8; ++e) { wv[0][e] = cw[c0 + cgp * 8 + e]; wv[1][e] = cw[1536 + c0 + cgp * 8 + e]; wv[2][e] = cw[3072 + c0 + cgp * 8 + e]; wv[3][e] = cb[c0 + cgp * 8 + e]; }
#pragma unroll 1
        for (int half = 0; half < 2; ++half) {
            u32x4 u0[4], u1[4], u2[4];
#pragma unroll
            for (int i = 0; i < 4; ++i) { const int r = (tid >> 3) + 64 * (half * 4 + i), tpos = t0 + r;
                const bf16_t* pp = proj + (size_t)(b * SEQ + tpos) * 2048 + c0 + cgp * 8;
                u1[i] = *(const u32x4*)pp; u0[i] = (u32x4){0u, 0u, 0u, 0u}; u2[i] = (u32x4){0u, 0u, 0u, 0u};
                if (tpos > 0) u0[i] = *(const u32x4*)(pp - 2048);
                if (tpos < SEQ - 1) u2[i] = *(const u32x4*)(pp + 2048); }
#pragma unroll
            for (int i = 0; i < 4; ++i) { const int r = (tid >> 3) + 64 * (half * 4 + i); float x0[8], x1[8], x2[8], v[8]; unpack8(u0[i], x0); unpack8(u1[i], x1); unpack8(u2[i], x2);
#pragma unroll
                for (int e = 0; e < 8; ++e) v[e] = wv[3][e] + wv[0][e] * x0[e] + wv[1][e] * x1[e] + wv[2][e] * x2[e];
                *(u32x4*)(tile + r * 72 + cgp * 8) = pack8(v); }
        }
        __syncthreads();
        bf16_t* tileT = tile + 512 * 72;
#pragma unroll
        for (int i = 0; i < 8; ++i) { const int task = tid + 512 * i, c = task & 63, tg = task >> 6; const bf16_t* sp = tile + (tg * 8) * 72 + c; u32x4 w;
            w.x = (unsigned)sp[0] | ((unsigned)sp[72] << 16); w.y = (unsigned)sp[144] | ((unsigned)sp[216] << 16); w.z = (unsigned)sp[288] | ((unsigned)sp[360] << 16); w.w = (unsigned)sp[432] | ((unsigned)sp[504] << 16);
            *(u32x4*)(tileT + c * 520 + tg * 8) = w; }
        __syncthreads();
#pragma unroll
        for (int i = 0; i < 8; ++i) { const int task = tid + 512 * i, c = task >> 6, tg = task & 63;
            *(u32x4*)(hyT + ((size_t)(c0 + c) * 4 + b) * SEQ + t0 + tg * 8) = *(const u32x4*)(tileT + c * 520 + tg * 8); }
    }
}
__device__ __forceinline__ void hy_post(KPR p, unsigned char* smem) {
    bf16_t* tile = (bf16_t*)smem;
    bf16_t* tileT = tile + 64 * 520;
    const bf16_t* proj = (const bf16_t*)(p.ws + WS_PROJ); const bf16_t* hyT = (const bf16_t*)(p.ws + WS_AUX); bf16_t* Y = (bf16_t*)(p.ws + WS_Y);
    const int tid = ltid();
    for (int it = blockIdx.x; it < 8 * 64; it += gridDim.x) {
        const int ct = it & 7, tt = it >> 3, b = tt >> 4, t0 = (tt & 15) * 512;
        { u32x4 tv[8];
#pragma unroll
          for (int i = 0; i < 8; ++i) { const int task = tid + 512 * i, c = task >> 6, tg = task & 63; tv[i] = *(const u32x4*)(hyT + ((size_t)(ct * 64 + c) * 4 + b) * SEQ + t0 + tg * 8); }
#pragma unroll
          for (int i = 0; i < 8; ++i) { const int task = tid + 512 * i, c = task >> 6, tg = task & 63; *(u32x4*)(tile + c * 520 + tg * 8) = tv[i]; } }
        __syncthreads();
#pragma unroll
        for (int i = 0; i < 8; ++i) { const int task = tid + 512 * i, t = task & 511, cgp = task >> 9; const bf16_t* sp = tile + (cgp * 8) * 520 + t; u32x4 w;
            w.x = (unsigned)sp[0] | ((unsigned)sp[520] << 16); w.y = (unsigned)sp[1040] | ((unsigned)sp[1560] << 16); w.z = (unsigned)sp[2080] | ((unsigned)sp[2600] << 16); w.w = (unsigned)sp[3120] | ((unsigned)sp[3640] << 16);
            *(u32x4*)(tileT + t * 72 + cgp * 8) = w; }
        __syncthreads();
        { u32x4 gu[8];
#pragma unroll
          for (int i = 0; i < 8; ++i) { const int task = tid + 512 * i, r = task >> 3, cgp = task & 7; gu[i] = *(const u32x4*)(proj + ((size_t)b * SEQ + t0 + r) * 2048 + 1536 + ct * 64 + cgp * 8); }
#pragma unroll
          for (int i = 0; i < 8; ++i) { const int task = tid + 512 * i, r = task >> 3, cgp = task & 7; float gv[8], v[8]; unpack8(gu[i], gv); unpack8(*(const u32x4*)(tileT + r * 72 + cgp * 8), v);
#pragma unroll
              for (int e = 0; e < 8; ++e) v[e] *= silu_f(gv[e]);
              *(u32x4*)(Y + ((size_t)b * SEQ + t0 + r) * 2048 + ct * 64 + cgp * 8) = pack8(v); } }
    }
}
typedef float f32x2v __attribute__((ext_vector_type(2)));
__device__ __forceinline__ f32x2v cmul(f32x2v a, f32x2v b) {
    f32x2v t, r;
    asm("v_pk_mul_f32 %0, %1, %2 op_sel:[0,0] op_sel_hi:[0,1]" : "=&v"(t) : "v"(a), "v"(b));
    asm("v_pk_fma_f32 %0, %1, %2, %3 op_sel:[1,1,0] op_sel_hi:[1,0,1] neg_lo:[0,1,0]" : "=&v"(r) : "v"(a), "v"(b), "v"(t));
    return r;
}
__device__ __forceinline__ f32x2v cmulc(f32x2v a, f32x2v b) {
    f32x2v t, r;
    asm("v_pk_mul_f32 %0, %1, %2 op_sel:[0,0] op_sel_hi:[0,1] neg_hi:[0,1]" : "=&v"(t) : "v"(a), "v"(b));
    asm("v_pk_fma_f32 %0, %1, %2, %3 op_sel:[1,1,0] op_sel_hi:[1,0,1]" : "=&v"(r) : "v"(a), "v"(b), "v"(t));
    return r;
}
__device__ __forceinline__ constexpr float c16(int m) { return m == 0 ? 1.f : m == 1 ? 0.92387953251f : m == 2 ? 0.70710678119f : m == 3 ? 0.38268343237f : m == 4 ? 0.f : m == 5 ? -0.38268343237f : m == 6 ? -0.70710678119f : -0.92387953251f; }
__device__ __forceinline__ constexpr float s16(int m) { return m == 0 ? 0.f : m == 1 ? 0.38268343237f : m == 2 ? 0.70710678119f : m == 3 ? 0.92387953251f : m == 4 ? 1.f : m == 5 ? 0.92387953251f : m == 6 ? 0.70710678119f : 0.38268343237f; }
#define PIDX(i) ((i) + (((i) >> 6) << 2))
__device__ __forceinline__ constexpr int brev4(int i) { return ((i & 1) << 3) | ((i & 2) << 1) | ((i & 4) >> 1) | ((i & 8) >> 3); }
template <bool INV> __device__ __forceinline__ void r16_core(f32x2v (&x)[16], const f32x2v wa) {
    f32x2v w[16]; w[1] = wa; w[2] = cmul(wa, wa); w[3] = cmul(w[2], wa); w[4] = cmul(w[2], w[2]); w[5] = cmul(w[4], wa); w[6] = cmul(w[3], w[3]); w[7] = cmul(w[4], w[3]); w[8] = cmul(w[4], w[4]);
    w[9] = cmul(w[8], wa); w[10] = cmul(w[5], w[5]); w[11] = cmul(w[8], w[3]); w[12] = cmul(w[6], w[6]); w[13] = cmul(w[8], w[5]); w[14] = cmul(w[7], w[7]); w[15] = cmul(w[8], w[7]);
    if (!INV) {
#pragma unroll
        for (int h = 8; h >= 1; h >>= 1)
#pragma unroll
            for (int i = 0; i < 16; ++i) if ((i & h) == 0) { const int m = (i & (h - 1)) * (8 / h); const f32x2v a = x[i], b = x[i + h]; x[i] = a + b; const f32x2v d = a - b;
                x[i + h] = (m == 0) ? d : (m == 4) ? (f32x2v){d.y, -d.x} : cmul(d, (f32x2v){c16(m), -s16(m)}); }
#pragma unroll
        for (int i = 1; i < 16; ++i) x[i] = cmul(x[i], w[brev4(i)]);
    } else {
#pragma unroll
        for (int i = 1; i < 16; ++i) x[i] = cmulc(x[i], w[brev4(i)]);
#pragma unroll
        for (int h = 1; h <= 8; h <<= 1)
#pragma unroll
            for (int i = 0; i < 16; ++i) if ((i & h) == 0) { const int m = (i & (h - 1)) * (8 / h); const f32x2v b = x[i + h];
                const f32x2v t = (m == 0) ? b : (m == 4) ? (f32x2v){-b.y, b.x} : cmulc(b, (f32x2v){c16(m), -s16(m)}); const f32x2v a = x[i]; x[i] = a + t; x[i + h] = a - t; }
    }
}
template <int S, bool INV> __device__ __forceinline__ void r16_pass(f32x2v* buf) {
    const int tid = ltid();
#pragma unroll
    for (int r = 0; r < 2; ++r) { const int q = tid + 512 * r; int base; float f;
        if (S == 1024) { base = q; f = (float)q * (1.0f / 16384.0f); }
        else if (S == 64) { const int jj = q & 63; base = (q >> 6) * 1024 + jj; f = (float)jj * (1.0f / 1024.0f); }
        else { const int jj = q & 3; base = (q >> 2) * 64 + jj; f = (float)jj * (1.0f / 64.0f); }
        constexpr int PS = (S == 1024) ? 1088 : (S == 64) ? 68 : 4;
        f32x2v* bp = buf + PIDX(base); f32x2v x[16];
#pragma unroll
        for (int m = 0; m < 16; ++m) x[m] = bp[PS * m];
        f32x2v wa = {__builtin_amdgcn_cosf(f), -__builtin_amdgcn_sinf(f)};
        asm volatile("s_nop 1" : "+v"(wa));
        r16_core<INV>(x, wa);
#pragma unroll
        for (int m = 0; m < 16; ++m) bp[PS * m] = x[m]; }
    __syncthreads();
}
template <int MODE> __device__ __forceinline__ void r4_mid(f32x2v* buf, const f32x2v* G) {
    const int tid = ltid();
#pragma unroll 1
    for (int rb = 0; rb < 2; ++rb) {
        f32x4 g01[4], g23[4];
        if (MODE == 1) {
#pragma unroll
            for (int i = 0; i < 4; ++i) { const int q = tid + 512 * (rb * 4 + i); g01[i] = *(const f32x4*)(G + 4 * q); g23[i] = *(const f32x4*)(G + 4 * q + 2); } }
#pragma unroll
        for (int i = 0; i < 4; ++i) { const int q = tid + 512 * (rb * 4 + i); f32x2v* bp = buf + PIDX(4 * q);
            const f32x4 v01 = *(const f32x4*)bp, v23 = *(const f32x4*)(bp + 2);
            const f32x2v x0 = {v01[0], v01[1]}, x1 = {v01[2], v01[3]}, x2 = {v23[0], v23[1]}, x3 = {v23[2], v23[3]};
            const f32x2v a0 = x0 + x2, a2 = x0 - x2, a1 = x1 + x3, d = x1 - x3; const f32x2v a3 = {d.y, -d.x};
            f32x2v b0 = a0 + a1, b1 = a0 - a1, b2 = a2 + a3, b3 = a2 - a3;
            if (MODE == 1) {
                b0 = cmul(b0, (f32x2v){g01[i][0], g01[i][1]}); b1 = cmul(b1, (f32x2v){g01[i][2], g01[i][3]}); b2 = cmul(b2, (f32x2v){g23[i][0], g23[i][1]}); b3 = cmul(b3, (f32x2v){g23[i][2], g23[i][3]});
                const f32x2v c0 = b0 + b1, c1 = b0 - b1, c2 = b2 + b3, c3 = b2 - b3; const f32x2v t = {-c3.y, c3.x};
                b0 = c0 + c2; b2 = c0 - c2; b1 = c1 + t; b3 = c1 - t;
            }
            *(f32x4*)bp = (f32x4){b0.x, b0.y, b1.x, b1.y}; *(f32x4*)(bp + 2) = (f32x4){b2.x, b2.y, b3.x, b3.y}; }
    }
    __syncthreads();
}
__device__ __forceinline__ int brev14(int x) { return (int)(__brev((unsigned)x) >> 18); }
__device__ __forceinline__ void hy_fft(KPR p, int layer, unsigned char* smem) {
    f32x2v* buf = (f32x2v*)smem;
    f32x4* sW3 = (f32x4*)(smem + 139264); float* sDec = (float*)(smem + 139264 + 1024);
    f32x2v* Gs = (f32x2v*)(p.ws + WS_XN) + (size_t)blockIdx.x * 32768;
    f32x2v* Zs = (f32x2v*)(p.ws + WS_PROJ + (size_t)32768 * 2048 * 2) + (size_t)blockIdx.x * 8192;
    bf16_t* hyT = (bf16_t*)(p.ws + WS_AUX); const float* hid = (const float*)(p.ws + WS_HID) + (size_t)layer * 8192 * 64;
    const int tid = ltid();
    for (int c = blockIdx.x; c < 512; c += gridDim.x) {
        if (tid < 256) ((float*)sW3)[tid] = p.in[I_HYW3][(size_t)layer * 64 * 2048 + (tid >> 2) * 2048 + (tid & 3) * 512 + c];
        if (tid < 4) sDec[tid] = p.in[I_HYDECAY][layer * 2048 + tid * 512 + c];
        __syncthreads();
#ifndef REP_FILT
#define REP_FILT 1
#endif
#ifndef REP_CONV1
#define REP_CONV1 1
#endif
        for (int frep = 0; frep < REP_FILT; ++frep) {
#pragma unroll 1
        for (int i = 0; i < 4; ++i) { const int t = 4 * (tid + 512 * i); const float* hp = hid + t; f32x4 a0 = {0.f, 0.f, 0.f, 0.f}, a1 = a0, a2 = a0, a3 = a0;
#pragma unroll 1
            for (int kb = 0; kb < 64; kb += 32) { f32x4 hv[32];
#pragma unroll
                for (int k = 0; k < 32; ++k) hv[k] = *(const f32x4*)(hp + (size_t)(kb + k) * 8192);
#pragma unroll
                for (int k = 0; k < 32; ++k) { const f32x4 w = sW3[kb + k]; a0 += hv[k] * w[0]; a1 += hv[k] * w[1]; a2 += hv[k] * w[2]; a3 += hv[k] * w[3]; } }
#pragma unroll
            for (int e = 0; e < 4; ++e) { const int te = t + e; const float tn = (float)te * (1.0f / 8192.0f);
                buf[PIDX(te)] = (f32x2v){a0[e] * __expf(-tn * sDec[0]), a2[e] * __expf(-tn * sDec[2])};
                if (te >= 1) buf[PIDX(16384 - te)] = (f32x2v){a1[e] * __expf(-tn * sDec[1]), a3[e] * __expf(-tn * sDec[3])}; else buf[PIDX(8192)] = (f32x2v){0.f, 0.f}; } }
        __syncthreads();
        r16_pass<1024, false>(buf); r16_pass<64, false>(buf); r16_pass<4, false>(buf); r4_mid<0>(buf, nullptr);
        const float skip0 = p.in[I_HYSKIP][layer * 1024 + c], skip1 = p.in[I_HYSKIP][layer * 1024 + 512 + c];
#pragma unroll 4
        for (int r = 0; r < 32; ++r) { const int pz = tid + 512 * r, k = brev14(pz), pm = brev14((16384 - k) & 16383);
            const f32x2v Z = buf[PIDX(pz)], Zm = buf[PIDX(pm)]; const float hs = 0.5f / 16384.0f;
            Gs[pz] = (f32x2v){(Z.x + Zm.x) * hs + skip0 * (1.0f / 16384.0f), (Z.y - Zm.y) * hs}; Gs[16384 + pz] = (f32x2v){(Z.y + Zm.y) * hs + skip1 * (1.0f / 16384.0f), (Zm.x - Z.x) * hs}; }
        __syncthreads(); }
#pragma unroll 1
        for (int pr = 0; pr < 2; ++pr) {
            bf16_t* v0 = hyT + ((size_t)c * 4 + 2 * pr) * SEQ; bf16_t* v1 = v0 + SEQ;
            const bf16_t* p0 = hyT + ((size_t)(512 + c) * 4 + 2 * pr) * SEQ; const bf16_t* p1 = p0 + SEQ;
            const bf16_t* q0 = hyT + ((size_t)(1024 + c) * 4 + 2 * pr) * SEQ; const bf16_t* q1 = q0 + SEQ;
            u32x4 uv0[2], uv1[2], ux0[2], ux1[2], uy0[2], uy1[2];
#pragma unroll
            for (int r = 0; r < 2; ++r) { const int t0 = 8 * (tid + 512 * r); uv0[r] = *(const u32x4*)(v0 + t0); uv1[r] = *(const u32x4*)(v1 + t0);
                ux0[r] = *(const u32x4*)(p0 + t0); ux1[r] = *(const u32x4*)(p1 + t0); uy0[r] = *(const u32x4*)(q0 + t0); uy1[r] = *(const u32x4*)(q1 + t0); }
            for (int crep = 0; crep < REP_CONV1; ++crep) {
#pragma unroll
            for (int r = 0; r < 2; ++r) { const int t0 = 8 * (tid + 512 * r); float a[8], b[8]; unpack8(uv0[r], a); unpack8(uv1[r], b);
                f32x4* bp = (f32x4*)(buf + PIDX(t0)); f32x4* bz = (f32x4*)(buf + PIDX(8192 + t0));
#pragma unroll
                for (int e = 0; e < 4; ++e) { bp[e] = (f32x4){a[2 * e], b[2 * e], a[2 * e + 1], b[2 * e + 1]}; bz[e] = (f32x4){0.f, 0.f, 0.f, 0.f}; } }
            __syncthreads();
            r16_pass<1024, false>(buf); r16_pass<64, false>(buf); r16_pass<4, false>(buf); r4_mid<1>(buf, Gs);
            r16_pass<4, true>(buf); r16_pass<64, true>(buf); r16_pass<1024, true>(buf);
#pragma unroll
            for (int r = 0; r < 2; ++r) { const int t0 = 8 * (tid + 512 * r); float a[8], b[8], xa[8], xb[8];
                unpack8(uv0[r], a); unpack8(uv1[r], b); unpack8(ux0[r], xa); unpack8(ux1[r], xb);
                f32x4* bp = (f32x4*)(buf + PIDX(t0)); f32x4* bz = (f32x4*)(buf + PIDX(8192 + t0));
#pragma unroll
                for (int e = 0; e < 4; ++e) { const f32x4 cv = bp[e];
                    const f32x4 z = {xa[2 * e] * cv[0], xb[2 * e] * cv[1], xa[2 * e + 1] * cv[2], xb[2 * e + 1] * cv[3]};
                    bp[e] = z; bz[e] = (f32x4){0.f, 0.f, 0.f, 0.f}; } }
            __syncthreads(); }
            r16_pass<1024, false>(buf); r16_pass<64, false>(buf); r16_pass<4, false>(buf); r4_mid<1>(buf, Gs + 16384);
            r16_pass<4, true>(buf); r16_pass<64, true>(buf); r16_pass<1024, true>(buf);
#pragma unroll
            for (int r = 0; r < 2; ++r) { const int t0 = 8 * (tid + 512 * r); float xa[8], xb[8], ya[8], yb[8];
                unpack8(uy0[r], xa); unpack8(uy1[r], xb);
                const f32x4* bp = (const f32x4*)(buf + PIDX(t0));
#pragma unroll
                for (int e = 0; e < 4; ++e) { const f32x4 cv = bp[e];
                    ya[2 * e] = xa[2 * e] * cv[0]; yb[2 * e] = xb[2 * e] * cv[1]; ya[2 * e + 1] = xa[2 * e + 1] * cv[2]; yb[2 * e + 1] = xb[2 * e + 1] * cv[3]; }
                *(u32x4*)(v0 + t0) = pack8(ya); *(u32x4*)(v1 + t0) = pack8(yb); }
            __syncthreads();
        }
    }
}
__global__ void __launch_bounds__(512) hybrid_fwd(Params p_unused) {
#define p (*kp())
    extern __shared__ __attribute__((aligned(16))) unsigned char smem[];
    cg::grid_group grid = cg::this_grid();
    volatile LAS unsigned* bst = (volatile LAS unsigned*)(smem + LDS_BYTES - 16);
    if (threadIdx.x < 4) bst[threadIdx.x] = 0u;
    __syncthreads();
    (void)xcd_barrier_post((unsigned*)(p.ws + WS_BAR), bst);
#define GSYNC() do { unsigned _z = 0u; asm volatile("" : "+v"(_z)); unsigned* _bar = (unsigned*)(p.ws + WS_BAR) + _z; XcdBarrier _b; _b.bar = _bar; _b.x = xb_xcc_id(); _b.st = bst; xcd_barrier(_b); } while (0)
    bf16_t* WBT = (bf16_t*)(p.ws + WS_WBT); bf16_t* WOT = (bf16_t*)(p.ws + WS_WOT); bf16_t* XN = (bf16_t*)(p.ws + WS_XN); float* SPEC = (float*)(p.ws + WS_SPEC);
    bf16_t* Yb = (bf16_t*)(p.ws + WS_Y); bf16_t* PROJ = (bf16_t*)(p.ws + WS_PROJ);
    for (int l = 0; l < 2; ++l) {
        conv_wt(p.in[I_WIN] + (size_t)l * 1024 * 8224, 1024, 8224, WBT + (size_t)l * 8224 * 1024, 8224, 1, smem);
        conv_wt(p.in[I_WOUT] + (size_t)l * 2048 * 1024, 2048, 1024, WOT + (size_t)l * 1024 * 2048, 1024, 0, smem);
    }
    hid_phase(p, smem);
    if (p.ws == nullptr) grid.sync();
    GSYNC();
#ifndef REP_M1A
#define REP_M1A 1
#endif
#ifndef REP_M3A
#define REP_M3A 1
#endif
#ifndef REP_M1B
#define REP_M1B 1
#endif
#ifndef REP_M3B
#define REP_M3B 1
#endif
#ifndef REP_POST
#define REP_POST 1
#endif
#ifndef REP_NORM
#define REP_NORM 1
#endif
#ifndef REP_GEMM
#define REP_GEMM 1
#endif
#ifndef REP_MB
#define REP_MB 1
#endif
#ifndef REP_ML
#define REP_ML 1
#endif
#ifndef REP_NA
#define REP_NA 1
#endif
#ifndef REP_HY
#define REP_HY 1
#endif
#ifndef REP_SYNC
#define REP_SYNC 0
#endif
    for (int l = 0; l < 2; ++l) {
        const float* xin = (l == 0) ? p.in[I_X] : p.out;
        const bf16_t* Wl = WBT + (size_t)l * 8224 * 1024;
        for (int r6 = 0; r6 < REP_NORM; ++r6) { norm_phase(xin, p.in[I_NORMW] + l * 1024, Wl + (size_t)8192 * 1024, XN, SPEC, smem);
        GSYNC(); }
        for (int rep = 0; rep < REP_GEMM; ++rep) { run_gemm(smem, XN, Wl + (size_t)2048 * 1024, NTOK, 1536, 1024, EpiProj{PROJ, 1536});
        GSYNC(); }
        for (int rep = 0; rep < REP_MB; ++rep) {
        for (int r1 = 0; r1 < REP_M1A; ++r1) { ssd_m1<0>(p, l, smem); GSYNC(); }
        ssd_m2<0>(p); GSYNC();
        for (int r3 = 0; r3 < REP_M3A; ++r3) { ssd_m3_mamba(p, l, smem); GSYNC(); } }
        for (int rep = 0; rep < REP_SYNC; ++rep) GSYNC();
        for (int rep = 0; rep < REP_GEMM; ++rep) { run_gemm(smem, XN, Wl + (size_t)3584 * 1024, NTOK, 2560, 1024, EpiProj{PROJ, 2560});
        GSYNC(); }
        for (int rep = 0; rep < REP_ML; ++rep) {
        for (int r1 = 0; r1 < REP_M1B; ++r1) { ssd_m1<1>(p, l, smem); GSYNC(); }
        ssd_m2<1>(p); GSYNC();
        for (int r3 = 0; r3 < REP_M3B; ++r3) { ssd_m3<1>(p, l, smem); GSYNC(); } }
        for (int rep = 0; rep < REP_GEMM; ++rep) { run_gemm(smem, XN, Wl + (size_t)6144 * 1024, NTOK, 2048, 1024, EpiProj{PROJ, 2048});
        GSYNC(); }
        for (int rep = 0; rep < REP_NA; ++rep) { na_phase(p, l, smem); GSYNC(); }
        for (int rep = 0; rep < REP_GEMM; ++rep) { run_gemm(smem, XN, Wl, NTOK, 2048, 1024, EpiProj{PROJ, 2048});
        GSYNC(); }
#ifndef REP_HYPREP
#define REP_HYPREP 1
#endif
        for (int rep = 0; rep < REP_HY; ++rep) {
        for (int rep2 = 0; rep2 < REP_HYPREP; ++rep2) { hy_prep(p, l, smem); GSYNC(); }
        hy_fft(p, l, smem); GSYNC(); }
        for (int r5 = 0; r5 < REP_POST; ++r5) { hy_post(p, smem); GSYNC(); }
        run_gemm(smem, Yb, WOT + (size_t)l * 1024 * 2048, NTOK, 1024, 2048, EpiResid{p.out, xin, 1024});
        if (l == 0) GSYNC();
    }
}

#undef p
extern "C" void kernel_launch(void* const* d_in, const int* in_sizes, int n_in, void* d_out, int out_size, void* d_ws, size_t ws_size, hipStream_t stream) {
    static int grid = 0;
    if (grid == 0) {
        if (n_in != 27 || ws_size < WS_END) { fprintf(stderr, "kernel_launch: need 27 inputs and %zu bytes of workspace (got %d, %zu)\n", (size_t)WS_END, n_in, ws_size); grid = -1; return; }
        int dev = 0, cus = 0, per_cu = 0;
        hipGetDevice(&dev); hipDeviceGetAttribute(&cus, hipDeviceAttributeMultiprocessorCount, dev);
        if (hipFuncSetAttribute((const void*)hybrid_fwd, hipFuncAttributeMaxDynamicSharedMemorySize, LDS_BYTES) != hipSuccess) { fprintf(stderr, "kernel_launch: hipFuncSetAttribute failed\n"); grid = -1; return; }
        if (hipOccupancyMaxActiveBlocksPerMultiprocessor(&per_cu, (const void*)hybrid_fwd, 512, LDS_BYTES) != hipSuccess || per_cu < 1) { fprintf(stderr, "kernel_launch: occupancy query failed (%d)\n", per_cu); grid = -1; return; }
        grid = cus * per_cu; if (grid > 256) grid = 256;
    }
    if (grid < 0) return;
    if (hipMemsetAsync((char*)d_ws + WS_BAR, 0, 16384, stream) != hipSuccess) { fprintf(stderr, "kernel_launch: memset of barrier words failed\n"); return; }
    Params p{};
    for (int i = 0; i < 27; ++i) p.in[i] = (const float*)d_in[i];
    p.out = (float*)d_out; p.ws = (unsigned char*)d_ws;
    void* args[] = {&p};
    hipError_t e = hipLaunchCooperativeKernel((const void*)hybrid_fwd, dim3(grid), dim3(512), args, LDS_BYTES, stream);
    if (e != hipSuccess) fprintf(stderr, "cooperative launch failed: %s (grid %d)\n", hipGetErrorString(e), grid);
}
```

```cpp
#include <hip/hip_runtime.h>
#include <hip/hip_cooperative_groups.h>
#include <cstdio>
namespace cg = cooperative_groups;
__device__ __forceinline__ int ltid() { int t = threadIdx.x; asm volatile("" : "+v"(t)); return t; }

#define XB_TMO      128
#define XB_XCNT(j)  (256  + 64 * (j))
#define XB_XSUB(j)  (1280 + 64 * (j))
#define XB_XGEN(j)  (2304 + 64 * (j))
#define XB_TOP      3328
#define XB_TOPGEN   3392
#define XCD_BAR_WORDS 3456
#define XB_SPIN_CAP (1u << 18)
#define LAS __attribute__((address_space(3)))

__device__ __forceinline__ unsigned xb_ld(unsigned* p)              { return __hip_atomic_load(p, __ATOMIC_RELAXED, __HIP_MEMORY_SCOPE_AGENT); }
__device__ __forceinline__ unsigned xb_add(unsigned* p, unsigned v) { return __hip_atomic_fetch_add(p, v, __ATOMIC_RELAXED, __HIP_MEMORY_SCOPE_AGENT); }
__device__ __forceinline__ unsigned xb_xcc_id() { return (unsigned)__builtin_amdgcn_s_getreg((3 << 11) | 20) & 0xFu; }
#define XB_SPIN(cond, bar) do { unsigned _sp = 0; while (cond) { __builtin_amdgcn_s_sleep(1); \
    if ((++_sp & 255u) == 0u) { if (xb_ld(&(bar)[XB_TMO])) break; if (_sp > XB_SPIN_CAP) { atomicAdd(&(bar)[XB_TMO], 1u); break; } } } } while (0)

struct XcdBarrier {
    unsigned* bar; unsigned x;
    volatile LAS unsigned* st;
};

__device__ __forceinline__ XcdBarrier xcd_barrier_post(unsigned* bar, volatile LAS unsigned* st) {
    XcdBarrier b; b.bar = bar; b.x = xb_xcc_id(); b.st = st;
    if (threadIdx.x == 0) (void)xb_add(&bar[XB_XCNT(b.x)], 1u);
    return b;
}
__device__ __forceinline__ void xcd_barrier_complete(unsigned* bar, unsigned x, unsigned& nloc, unsigned& nx) {
    const unsigned G = gridDim.x * gridDim.y * gridDim.z;
    unsigned sum, cnt, mine, sp = 0u;
    for (;;) {
        sum = 0u; cnt = 0u; mine = 0u;
#pragma unroll
        for (unsigned j = 0; j < 16; ++j) { const unsigned c = xb_ld(&bar[XB_XCNT(j)]); sum += c; cnt += (c > 0u) ? 1u : 0u; mine = (j == x) ? c : mine; }
        if (sum == G) break;
        __builtin_amdgcn_s_sleep(1);
        if ((++sp & 255u) == 0u) { if (xb_ld(&bar[XB_TMO])) break; if (sp > XB_SPIN_CAP) { atomicAdd(&bar[XB_TMO], 1u); break; } }
    }
    nloc = mine > 0u ? mine : 1u; nx = cnt > 0u ? cnt : 1u;
}

__device__ __forceinline__ void xcd_barrier(const XcdBarrier& b) {
    asm volatile("s_waitcnt vmcnt(0)" ::: "memory");
    __syncthreads();
    if (threadIdx.x == 0) {
        unsigned* bar = b.bar;
        __builtin_amdgcn_s_waitcnt(0);
        unsigned nloc = b.st[0], nx = b.st[1];
        if (nloc == 0u) { xcd_barrier_complete(bar, b.x, nloc, nx); b.st[0] = nloc; b.st[1] = nx; }
        const unsigned old = xb_add(&bar[XB_XSUB(b.x)], 1u);
        const unsigned gen = old / nloc;
        if (old + 1u == (gen + 1u) * nloc) {
            __builtin_amdgcn_fence(__ATOMIC_RELEASE, "agent");
            asm volatile("s_waitcnt vmcnt(0)" ::: "memory");
            const unsigned og = xb_add(&bar[XB_TOP], 1u);
            const unsigned tg = og / nx;
            if (og + 1u == (tg + 1u) * nx) xb_add(&bar[XB_TOPGEN], 1u);
            else XB_SPIN(xb_ld(&bar[XB_TOPGEN]) == tg, bar);
            __builtin_amdgcn_fence(__ATOMIC_ACQUIRE, "agent");
            xb_add(&bar[XB_XGEN(b.x)], 1u);
            asm volatile("s_waitcnt vmcnt(0)" ::: "memory");
        } else {
            XB_SPIN(xb_ld(&bar[XB_XGEN(b.x)]) == gen, bar);
            __builtin_amdgcn_fence(__ATOMIC_ACQUIRE, "agent");
            asm volatile("s_waitcnt vmcnt(0)" ::: "memory");
        }
    }
    __syncthreads();
}
namespace pg8 {
#define PG8_LAS __attribute__((address_space(3)))
typedef unsigned short bf16_t;
typedef short bf16x8 __attribute__((ext_vector_type(8)));
typedef float f32x4 __attribute__((ext_vector_type(4)));
typedef unsigned u32x4 __attribute__((ext_vector_type(4)));
constexpr int BM = 256, BK = 64, HALF = 128, HTB = HALF * BK * 2  , STAGE_BYTES = 8 * HTB, NXCD = 8, WGM = 8;

__host__ __device__ __forceinline__ int lds_byte(int r, int c) { const int st = (r >> 4) * 2 + (c >> 5), rr = r & 15, cc = c & 31, ob = rr * 64 + cc * 2; return st * 1024 + (ob ^ (((ob >> 9) & 1) << 5)); }
__host__ __device__ __forceinline__ void stage_rc(int b, int& R, int& C) { const int st = b / 1024, sb = b % 1024, swz = sb ^ (((sb >> 9) & 1) << 5); R = (st >> 1) * 16 + swz / 64; C = (st & 1) * 32 + (swz % 64) / 2; }
__host__ __device__ __forceinline__ int perm32(int rho) { const int n = rho >> 4, i = rho & 15; return 8 * (i >> 2) + 4 * n + (i & 3); }

struct Unit { int pm, pn; };
struct Gemm { const bf16_t* A; const bf16_t* Bt; int M, N, K; };

struct StaticOrder {
    int nM, nN, nwg, G, c;
    __host__ __device__ void init(int M, int N, int G_, int c_) { nM = M / BM; nN = N / BM; nwg = nM * nN; G = G_; c = c_; }
    __host__ __device__ bool next(int i, Unit& u) const {
        const long L = (long)i * G + c; if (L >= nwg) return false;
        int wgid = (int)L; { const int q = nwg / NXCD, r = nwg % NXCD, xcd = wgid % NXCD, off = wgid / NXCD; wgid = (xcd < r ? xcd * (q + 1) : r * (q + 1) + (xcd - r) * q) + off; }
        const int nig = WGM * nN, gid = wgid / nig, fm = gid * WGM, gsz = (nM - fm) < WGM ? (nM - fm) : WGM;
        u.pm = fm + ((wgid % nig) % gsz); u.pn = (wgid % nig) / gsz; return true;
    }
    __device__ __forceinline__ void a_ready(const Unit&) const {}
    __device__ __forceinline__ void done(const Unit&) const {}
};
__device__ __forceinline__ unsigned cvt_pk_bf16(float lo, float hi) { unsigned r; asm volatile("v_cvt_pk_bf16_f32 %0, %1, %2" : "=v"(r) : "v"(lo), "v"(hi)); return r; }
template <class Epi, class Sched, bool ALIGN_EPI = false, bool SP2 = false>
__device__ __forceinline__ void gemm_phase(PG8_LAS unsigned char* lds, const Gemm g, const Sched& S, const Epi& E) {
    const int tid = ltid(), wid = __builtin_amdgcn_readfirstlane(tid >> 6), lane = tid & 63, wr = wid >> 2, wc = wid & 3, fr = lane & 15, fq = lane >> 4;
    const int K = g.K, nt = K / BK;
    unsigned voffA[2], voffB[2];
#pragma unroll
    for (int i = 0; i < 2; ++i) { int R, C; stage_rc(tid * 16 + i * 8192, R, C); const int Rb = Epi::PERM ? ((R & ~31) + perm32(R & 31)) : R;
        voffA[i] = (unsigned)(R * K + C) * 2u; voffB[i] = (unsigned)(Rb * K + C) * 2u; }
    const size_t kstep = (size_t)(BK * 2);
    const size_t hstep = (size_t)HALF * K * 2;
    const size_t tstep = 2 * hstep;
    const unsigned ldsw = (unsigned)wid * 1024u;
    const int aoff = lds_byte(wr * 64 + fr, fq * 8), boff = lds_byte(wc * 32 + fr, fq * 8);
#define PG8_SA(b, h) (((b) * 2 + (h)) * HTB)
#define PG8_SB(b, h) ((4 + (b) * 2 + (h)) * HTB)
#define PG8_STAGE(bufoff, gbase, voff) do { _Pragma("unroll") for (int _i = 0; _i < 2; ++_i) \
        __builtin_amdgcn_global_load_lds((const unsigned*)((const char*)(gbase) + (voff)[_i]), (PG8_LAS unsigned*)(lds + (bufoff) + ldsw + _i * 8192), 16, 0, 0); } while (0)
#define PG8_LDA(dst, b, h) do { _Pragma("unroll") for (int m = 0; m < 4; ++m) _Pragma("unroll") for (int k = 0; k < 2; ++k) dst[m][k] = *(const PG8_LAS bf16x8*)(lds + PG8_SA(b, h) + aoff + m * 2048 + k * 1024); } while (0)
#define PG8_LDB(dst, b, h) do { _Pragma("unroll") for (int n = 0; n < 2; ++n) _Pragma("unroll") for (int k = 0; k < 2; ++k) dst[n][k] = *(const PG8_LAS bf16x8*)(lds + PG8_SB(b, h) + boff + n * 2048 + k * 1024); } while (0)
#define PG8_MMA(ai, bj, At, Bt) do { __builtin_amdgcn_s_setprio(1); _Pragma("unroll") for (int m = 0; m < 4; ++m) _Pragma("unroll") for (int n = 0; n < 2; ++n) _Pragma("unroll") for (int k = 0; k < 2; ++k) \
        acc[ai][bj][m][n] = __builtin_amdgcn_mfma_f32_16x16x32_bf16(Bt[n][k], At[m][k], acc[ai][bj][m][n], 0, 0, 0); __builtin_amdgcn_s_setprio(0); } while (0)
#define PG8_WAIT_V(n) asm volatile("s_waitcnt vmcnt(" #n ")" ::: "memory")
#define PG8_WAIT_L(n) asm volatile("s_waitcnt lgkmcnt(" #n ")" ::: "memory")
#define PG8_BAR __builtin_amdgcn_s_barrier()
#define PG8_SCHED __builtin_amdgcn_sched_barrier(0)
    Unit cur, nxt; int ui = 0;
    if (!S.next(0, cur)) return;
    f32x4 acc[2][2][4][2];
#pragma unroll
    for (int a = 0; a < 2; ++a)
#pragma unroll
        for (int b = 0; b < 2; ++b)
#pragma unroll
            for (int m = 0; m < 4; ++m)
#pragma unroll
                for (int n = 0; n < 2; ++n) acc[a][b][m][n] = (f32x4){0.f, 0.f, 0.f, 0.f};
    bf16x8 At[4][2], B0[2][2], B1[2][2];
    const char* cA = (const char*)g.A + (size_t)cur.pm * tstep; const char* cB = (const char*)g.Bt + (size_t)cur.pn * tstep;
    S.a_ready(cur);
    if constexpr (SP2) {
        PG8_STAGE(PG8_SB(0, 0), cB, voffB); PG8_STAGE(PG8_SB(0, 1), cB + hstep, voffB); PG8_STAGE(PG8_SA(0, 0), cA, voffA); PG8_STAGE(PG8_SA(0, 1), cA + hstep, voffA);
        if (wr == 1) PG8_BAR;
        PG8_WAIT_V(2); PG8_BAR;
        PG8_STAGE(PG8_SB(1, 0), cB + kstep, voffB); PG8_STAGE(PG8_SA(1, 0), cA + kstep, voffA); PG8_STAGE(PG8_SB(1, 1), cB + hstep + kstep, voffB);
        PG8_WAIT_V(6); PG8_BAR;
    } else {
        PG8_STAGE(PG8_SB(0, 0), cB, voffB); PG8_STAGE(PG8_SA(0, 0), cA, voffA); PG8_STAGE(PG8_SB(0, 1), cB + hstep, voffB); PG8_STAGE(PG8_SA(0, 1), cA + hstep, voffA);
        if (wr == 1) PG8_BAR;
        PG8_WAIT_V(4); PG8_BAR;
        PG8_STAGE(PG8_SB(1, 0), cB + kstep, voffB); PG8_STAGE(PG8_SA(1, 0), cA + kstep, voffA); PG8_STAGE(PG8_SB(1, 1), cB + hstep + kstep, voffB);
        PG8_WAIT_V(6); PG8_BAR;
    }
    for (;;) {
        const bool has_next = S.next(ui + 1, nxt);
        const char* nA = has_next ? (const char*)g.A + (size_t)nxt.pm * tstep : cA; const char* nB = has_next ? (const char*)g.Bt + (size_t)nxt.pn * tstep : cB;
        for (int t = 0; t < nt; t += 2) {
            const bool last = (t == nt - 2);
            const char* a1 = cA + (size_t)(t + 1) * kstep;
            const char* a2 = last ? nA : cA + (size_t)(t + 2) * kstep; const char* b2 = last ? nB : cB + (size_t)(t + 2) * kstep;
            const char* a3 = a2 + kstep; const char* b3 = b2 + kstep;
            if (last && has_next) S.a_ready(nxt);
            if constexpr (SP2) {
            PG8_LDB(B0, 0, 0); PG8_LDB(B1, 0, 1); PG8_SCHED; PG8_LDA(At, 0, 0); PG8_STAGE(PG8_SA(1, 1), a1 + hstep, voffA);
            PG8_WAIT_V(8); PG8_WAIT_L(0); PG8_BAR; PG8_MMA(0, 0, At, B0); PG8_MMA(0, 1, At, B1); PG8_BAR; PG8_SCHED;
            PG8_LDA(At, 0, 1); PG8_STAGE(PG8_SB(0, 0), b2, voffB); PG8_STAGE(PG8_SB(0, 1), b2 + hstep, voffB); PG8_STAGE(PG8_SA(0, 0), a2, voffA);
            PG8_WAIT_V(8); PG8_WAIT_L(0); PG8_BAR; PG8_MMA(1, 0, At, B0); PG8_MMA(1, 1, At, B1); PG8_BAR; PG8_SCHED;
            PG8_LDB(B0, 1, 0); PG8_LDB(B1, 1, 1); PG8_SCHED; PG8_LDA(At, 1, 0); PG8_STAGE(PG8_SA(0, 1), a2 + hstep, voffA);
            PG8_WAIT_V(8); PG8_WAIT_L(0); PG8_BAR; PG8_MMA(0, 0, At, B0); PG8_MMA(0, 1, At, B1); PG8_BAR; PG8_SCHED;
            PG8_LDA(At, 1, 1); PG8_STAGE(PG8_SB(1, 0), b3, voffB); PG8_STAGE(PG8_SB(1, 1), b3 + hstep, voffB); PG8_STAGE(PG8_SA(1, 0), a3, voffA);
            PG8_WAIT_V(8); PG8_WAIT_L(0); PG8_BAR; PG8_MMA(1, 0, At, B0); PG8_MMA(1, 1, At, B1); PG8_BAR; PG8_SCHED;
            } else {
            PG8_LDB(B0, 0, 0); PG8_SCHED; PG8_LDA(At, 0, 0); PG8_STAGE(PG8_SA(1, 1), a1 + hstep, voffA);
            PG8_WAIT_L(8); PG8_BAR; PG8_WAIT_L(0); PG8_MMA(0, 0, At, B0); PG8_BAR; PG8_SCHED;
            PG8_LDB(B1, 0, 1); PG8_STAGE(PG8_SB(0, 0), b2, voffB);
            PG8_BAR; PG8_WAIT_L(0); PG8_MMA(0, 1, At, B1); PG8_BAR;
            PG8_LDA(At, 0, 1); PG8_STAGE(PG8_SA(0, 0), a2, voffA);
            PG8_BAR; PG8_WAIT_L(0); PG8_MMA(1, 0, At, B0); PG8_BAR; PG8_SCHED;
            PG8_STAGE(PG8_SB(0, 1), b2 + hstep, voffB);
            PG8_WAIT_V(6); PG8_BAR; PG8_MMA(1, 1, At, B1); PG8_BAR;
            PG8_LDB(B0, 1, 0); PG8_SCHED; PG8_LDA(At, 1, 0); PG8_STAGE(PG8_SA(0, 1), a2 + hstep, voffA);
            PG8_WAIT_L(8); PG8_BAR; PG8_WAIT_L(0); PG8_MMA(0, 0, At, B0); PG8_BAR; PG8_SCHED;
            PG8_LDB(B1, 1, 1); PG8_STAGE(PG8_SB(1, 0), b3, voffB);
            PG8_BAR; PG8_WAIT_L(0); PG8_MMA(0, 1, At, B1); PG8_BAR;
            PG8_LDA(At, 1, 1); PG8_STAGE(PG8_SA(1, 0), a3, voffA);
            PG8_BAR; PG8_WAIT_L(0); PG8_MMA(1, 0, At, B0); PG8_BAR; PG8_SCHED;
            PG8_STAGE(PG8_SB(1, 1), b3 + hstep, voffB);
            PG8_WAIT_V(6); PG8_BAR; PG8_MMA(1, 1, At, B1); PG8_BAR;
            }
        }
        if constexpr (ALIGN_EPI) { if (wr == 0) PG8_BAR; }
        if constexpr (!Epi::AFTER_DRAIN) { E(acc, cur, wr, wc, fr, fq); S.done(cur); }
        if (!has_next) break;
#pragma unroll
        for (int a = 0; a < 2; ++a)
#pragma unroll
            for (int b = 0; b < 2; ++b)
#pragma unroll
                for (int m = 0; m < 4; ++m)
#pragma unroll
                    for (int n = 0; n < 2; ++n) acc[a][b][m][n] = (f32x4){0.f, 0.f, 0.f, 0.f};
        cur = nxt; cA = nA; cB = nB; ++ui;
        if constexpr (ALIGN_EPI) { if (wr == 1) PG8_BAR; }
    }
    PG8_WAIT_V(0);
    if constexpr (!ALIGN_EPI) { if (wr == 0) PG8_BAR; }
    PG8_BAR;
    if constexpr (Epi::AFTER_DRAIN) { E.fused(acc, cur, wr, wc, fr, fq, lds, wid, lane); S.done(cur); }
#undef PG8_SA
#undef PG8_SB
#undef PG8_STAGE
#undef PG8_LDA
#undef PG8_LDB
#undef PG8_MMA
#undef PG8_WAIT_V
#undef PG8_WAIT_L
#undef PG8_BAR
#undef PG8_SCHED
}
}
using pg8::bf16_t; using pg8::bf16x8; using pg8::f32x4; using pg8::u32x4;
typedef unsigned u32x2 __attribute__((ext_vector_type(2)));

constexpr int SEQ = 8192, NTOK = 32768;
constexpr int LDS_BYTES = 160 * 1024;
constexpr size_t WS_WBT  = 0;
constexpr size_t WS_WOT  = WS_WBT + (size_t)2 * 8224 * 1024 * 2;
constexpr size_t WS_HID  = WS_WOT + (size_t)2 * 1024 * 2048 * 2;
constexpr size_t WS_XN   = WS_HID + (size_t)2 * 8192 * 64 * 4;
constexpr size_t WS_SPEC = WS_XN + (size_t)32768 * 1024 * 2;
constexpr size_t WS_Y    = WS_SPEC + (size_t)32768 * 32 * 4;
constexpr size_t WS_PROJ = WS_Y + (size_t)32768 * 2048 * 2;
constexpr size_t WS_AUX  = WS_PROJ + (size_t)32768 * 2560 * 2;
constexpr size_t WS_ATOT = WS_AUX + (size_t)3 * 512 * 32768 * 2;
constexpr size_t WS_BAR  = WS_ATOT + 65536;
constexpr size_t WS_END  = WS_BAR + 16384;

struct Params { const float* in[27]; float* out; unsigned char* ws; };
#define KPR const __attribute__((address_space(4))) Params&
__device__ __forceinline__ const __attribute__((address_space(4))) Params* kp() { auto k = __builtin_amdgcn_kernarg_segment_ptr(); asm volatile("" : "+s"(k)); return (const __attribute__((address_space(4))) Params*)k; }
enum { I_X = 0, I_NORMW, I_WIN, I_WOUT, I_HYCW, I_HYCB, I_HYW1, I_HYB1, I_HYW2, I_HYB2, I_HYW3, I_HYFREQ, I_HYDECAY, I_HYSKIP, I_MBCW, I_MBCB, I_MBDTB, I_MBALOG, I_MBD, I_MBNW,
       I_MLCW, I_MLCB, I_MLGB, I_MLNW, I_NAQN, I_NAKN, I_NARPB };

__device__ __forceinline__ float bf2f(bf16_t b) { return __uint_as_float(((unsigned)b) << 16); }
typedef __bf16 bf16v2_t __attribute__((ext_vector_type(2)));
__device__ __forceinline__ unsigned pk2(float lo, float hi) { bf16v2_t v; v[0] = (__bf16)lo; v[1] = (__bf16)hi; return __builtin_bit_cast(unsigned, v); }
__device__ __forceinline__ bf16_t f2bf(float f) { return __builtin_bit_cast(bf16_t, (__bf16)f); }
template <int E> __device__ __forceinline__ float bfe(const u32x4& u) { const unsigned w = u[E >> 1]; return (E & 1) ? __uint_as_float(w & 0xffff0000u) : __uint_as_float(w << 16); }
__device__ __forceinline__ void unpack8(const u32x4& u, float (&v)[8]) { v[0] = bfe<0>(u); v[1] = bfe<1>(u); v[2] = bfe<2>(u); v[3] = bfe<3>(u); v[4] = bfe<4>(u); v[5] = bfe<5>(u); v[6] = bfe<6>(u); v[7] = bfe<7>(u); }
__device__ __forceinline__ u32x4 pack8(const float (&v)[8]) { u32x4 w; w.x = pk2(v[0], v[1]); w.y = pk2(v[2], v[3]); w.z = pk2(v[4], v[5]); w.w = pk2(v[6], v[7]); return w; }
__device__ __forceinline__ float rcp_f(float x) { return __builtin_amdgcn_rcpf(x); }
typedef __bf16 bf16v2d_t __attribute__((ext_vector_type(2)));
__device__ __forceinline__ float sumsq8(const u32x4& u, float acc) {
    acc = __builtin_amdgcn_fdot2_f32_bf16(__builtin_bit_cast(bf16v2d_t, u.x), __builtin_bit_cast(bf16v2d_t, u.x), acc, false); acc = __builtin_amdgcn_fdot2_f32_bf16(__builtin_bit_cast(bf16v2d_t, u.y), __builtin_bit_cast(bf16v2d_t, u.y), acc, false);
    acc = __builtin_amdgcn_fdot2_f32_bf16(__builtin_bit_cast(bf16v2d_t, u.z), __builtin_bit_cast(bf16v2d_t, u.z), acc, false); acc = __builtin_amdgcn_fdot2_f32_bf16(__builtin_bit_cast(bf16v2d_t, u.w), __builtin_bit_cast(bf16v2d_t, u.w), acc, false); return acc; }
__device__ __forceinline__ float silu_f(float x) { return x * rcp_f(1.0f + __expf(-x)); }
__device__ __forceinline__ float sigmoid_f(float x) { return rcp_f(1.0f + __expf(-x)); }
__device__ __forceinline__ f32x4 mfma16(const bf16x8& a, const bf16x8& b, const f32x4& c) { return __builtin_amdgcn_mfma_f32_16x16x32_bf16(a, b, c, 0, 0, 0); }
__device__ __forceinline__ bf16x8 as_bf16x8(const u32x4& u) { union { u32x4 a; bf16x8 b; } x; x.a = u; return x.b; }
__device__ __forceinline__ int clampi(int v, int lo, int hi) { return v < lo ? lo : (v > hi ? hi : v); }

struct EpiProj {
    static constexpr bool PERM = true, AFTER_DRAIN = false;
    bf16_t* O; int ldc;
    __device__ __forceinline__ void operator()(const f32x4 (&acc)[2][2][4][2], const pg8::Unit& u, int wr, int wc, int fr, int fq) const {
        const int row0 = u.pm * 256 + wr * 64 + fr, col0 = u.pn * 256 + wc * 32 + 8 * fq;
#pragma unroll
        for (int ai = 0; ai < 2; ++ai)
#pragma unroll
            for (int m = 0; m < 4; ++m) { bf16_t* rowp = O + (size_t)(row0 + ai * 128 + m * 16) * ldc + col0;
#pragma unroll
                for (int bj = 0; bj < 2; ++bj) { const f32x4 v0 = acc[ai][bj][m][0], v1 = acc[ai][bj][m][1];
                    u32x4 w; w.x = pk2(v0[0], v0[1]); w.y = pk2(v0[2], v0[3]); w.z = pk2(v1[0], v1[1]); w.w = pk2(v1[2], v1[3]);
                    *(u32x4*)(rowp + bj * 128) = w; } }
    }
};
struct EpiResid {
    static constexpr bool PERM = false, AFTER_DRAIN = false;
    float* C; const float* R; int ldc;
    __device__ __forceinline__ void operator()(const f32x4 (&acc)[2][2][4][2], const pg8::Unit& u, int wr, int wc, int fr, int fq) const {
        const int row0 = u.pm * 256 + wr * 64 + fr, col0 = u.pn * 256 + wc * 32 + 4 * fq;
#pragma unroll
        for (int ai = 0; ai < 2; ++ai)
#pragma unroll
            for (int mp = 0; mp < 2; ++mp) { f32x4 rv[2][2][2];
#pragma unroll
                for (int mm = 0; mm < 2; ++mm) { const size_t off = (size_t)(row0 + ai * 128 + (mp * 2 + mm) * 16) * ldc + col0;
#pragma unroll
                    for (int bj = 0; bj < 2; ++bj)
#pragma unroll
                        for (int n = 0; n < 2; ++n) rv[mm][bj][n] = *(const f32x4*)(R + off + bj * 128 + n * 16); }
                asm volatile("" ::: "memory");
#pragma unroll
                for (int mm = 0; mm < 2; ++mm) { const size_t off = (size_t)(row0 + ai * 128 + (mp * 2 + mm) * 16) * ldc + col0;
#pragma unroll
                    for (int bj = 0; bj < 2; ++bj)
#pragma unroll
                        for (int n = 0; n < 2; ++n) *(f32x4*)(C + off + bj * 128 + n * 16) = rv[mm][bj][n] + acc[ai][bj][mp * 2 + mm][n]; }
                asm volatile("" ::: "memory"); }
    }
};
template <class Epi> __device__ __forceinline__ void run_gemm(unsigned char* smem, const bf16_t* A, const bf16_t* Bt, int M, int N, int K, const Epi& E) {
    pg8::Gemm g{A, Bt, M, N, K}; pg8::StaticOrder S; S.init(M, N, (int)gridDim.x, (int)blockIdx.x);
    pg8::gemm_phase<Epi, pg8::StaticOrder, true, true>((PG8_LAS unsigned char*)smem, g, S, E);
    __syncthreads();
}

__device__ __forceinline__ int win_col(int n) { return n < 3584 ? n : (n < 6144 ? n + 16 : (n < 8192 ? n + 32 : (n < 8208 ? n - 8192 + 3584 : n - 8208 + 6160))); }
__device__ __forceinline__ void conv_wt(const float* W, int K, int ldw, bf16_t* Bt, int nrows, int mapmode, unsigned char* smem) {
    float* tile = (float*)smem;
    const int tid = ltid(), ntn = nrows / 32, ntk = K / 128, ntot = ntn * ntk;
    for (int t0 = blockIdx.x * 4; t0 < ntot; t0 += gridDim.x * 4) {
        float v[4][8];
#pragma unroll
        for (int q = 0; q < 4; ++q) { const int t = t0 + q < ntot ? t0 + q : ntot - 1, tn = t % ntn, tk = t / ntn, n0 = tn * 32, k0 = tk * 128;
            const int nn = tid & 31, kk = tid >> 5, col = mapmode ? win_col(n0 + nn) : (n0 + nn);
#pragma unroll
            for (int i = 0; i < 8; ++i) v[q][i] = W[(size_t)(k0 + kk + 16 * i) * ldw + col]; }
#pragma unroll
        for (int q = 0; q < 4; ++q) { const int nn = tid & 31, kk = tid >> 5;
#pragma unroll
            for (int i = 0; i < 8; ++i) tile[q * 4128 + nn * 129 + kk + 16 * i] = v[q][i]; }
        __syncthreads();
#pragma unroll
        for (int q = 0; q < 4; ++q) if (t0 + q < ntot) { const int t = t0 + q, tn = t % ntn, tk = t / ntn, n0 = tn * 32, k0 = tk * 128; const int row = tid >> 4, kq = tid & 15; float o[8];
#pragma unroll
            for (int e = 0; e < 8; ++e) o[e] = tile[q * 4128 + row * 129 + kq * 8 + e];
            *(u32x4*)(Bt + (size_t)(n0 + row) * K + k0 + kq * 8) = pack8(o); }
        __syncthreads();
    }
}
__device__ __forceinline__ void hid_phase(KPR p, unsigned char* smem) {
    float* sF = (float*)smem; float* sH = sF + 8 * 20;
    float* hid = (float*)(p.ws + WS_HID);
    const int tid = ltid(), r = tid >> 6, j = tid & 63;
    int curl = -1; float w1r[17], w2r[64], fq = 0.f, b1 = 0.f, b2 = 0.f;
    for (int it = blockIdx.x; it < 2048; it += gridDim.x) {
        const int row = it * 8 + r, l = row >> 13, t = row & 8191;
        if (l != curl) { curl = l; fq = p.in[I_HYFREQ][l * 64 + j]; b1 = p.in[I_HYB1][l * 64 + j]; b2 = p.in[I_HYB2][l * 64 + j];
#pragma unroll
            for (int i = 0; i < 17; ++i) w1r[i] = p.in[I_HYW1][l * 17 * 64 + i * 64 + j];
#pragma unroll
            for (int k = 0; k < 64; ++k) w2r[k] = p.in[I_HYW2][l * 64 * 64 + k * 64 + j]; }
        if (j < 17) { float v;
            if (j == 0) v = (float)t * (1.0f / 8192.0f);
            else { const int band = (j <= 8) ? j : j - 8; const float fr = (float)((t * band) & 8191) * (1.0f / 8192.0f); v = (j <= 8) ? __builtin_amdgcn_cosf(fr) : __builtin_amdgcn_sinf(fr); }
            sF[r * 20 + j] = v; }
        __syncthreads();
        { float a = b1;
#pragma unroll
          for (int i = 0; i < 17; ++i) a += sF[r * 20 + i] * w1r[i];
          sH[r * 64 + j] = __sinf(fq * a); }
        __syncthreads();
        { float a = b2;
#pragma unroll
          for (int k4 = 0; k4 < 16; ++k4) { const f32x4 hv = *(const f32x4*)(sH + r * 64 + k4 * 4); a += hv[0] * w2r[k4 * 4] + hv[1] * w2r[k4 * 4 + 1] + hv[2] * w2r[k4 * 4 + 2] + hv[3] * w2r[k4 * 4 + 3]; }
          hid[((size_t)(l * 64 + j)) * 8192 + t] = __sinf(fq * a); }
        __syncthreads();
    }
}

__device__ __forceinline__ void norm_phase(const float* xin, const float* nw, const bf16_t* wsp, bf16_t* xn, float* spec, unsigned char* smem) {
    bf16_t* sA = (bf16_t*)smem;
    const int tid = ltid(), wid = tid >> 6, lane = tid & 63;
    f32x4 nwv[4];
#pragma unroll
    for (int i = 0; i < 4; ++i) nwv[i] = *(const f32x4*)(nw + lane * 4 + 256 * i);
    for (int it = blockIdx.x; it < 512; it += gridDim.x) {
        const int row0 = it * 64;
#pragma unroll 1
        for (int rb = 0; rb < 2; ++rb) {
            f32x4 v[4][4];
#pragma unroll
            for (int rr = 0; rr < 4; ++rr) { const float* xr = xin + (size_t)(row0 + wid * 8 + rb * 4 + rr) * 1024;
#pragma unroll
                for (int i = 0; i < 4; ++i) v[rr][i] = *(const f32x4*)(xr + lane * 4 + 256 * i); }
#pragma unroll
            for (int rr = 0; rr < 4; ++rr) { const int r = wid * 8 + rb * 4 + rr; float ss = 0.f;
#pragma unroll
                for (int i = 0; i < 4; ++i) ss += v[rr][i][0] * v[rr][i][0] + v[rr][i][1] * v[rr][i][1] + v[rr][i][2] * v[rr][i][2] + v[rr][i][3] * v[rr][i][3];
#pragma unroll
                for (int d = 32; d >= 1; d >>= 1) ss += __shfl_xor(ss, d);
                const float rstd = rsqrtf(ss * (1.0f / 1024.0f) + 1e-6f);
#pragma unroll
                for (int i = 0; i < 4; ++i) { const f32x4 w = nwv[i]; u32x2 o; o.x = pk2(v[rr][i][0] * rstd * w[0], v[rr][i][1] * rstd * w[1]); o.y = pk2(v[rr][i][2] * rstd * w[2], v[rr][i][3] * rstd * w[3]);
                    *(u32x2*)(xn + (size_t)(row0 + r) * 1024 + lane * 4 + 256 * i) = o; *(u32x2*)(sA + r * 1032 + lane * 4 + 256 * i) = o; } }
        }
        __syncthreads();
        { const int rt = wid >> 1, ct = wid & 1; f32x4 acc = {0.f, 0.f, 0.f, 0.f};
          const bf16_t* ap = sA + (rt * 16 + (lane & 15)) * 1032 + 8 * (lane >> 4); const bf16_t* bp = wsp + (size_t)(ct * 16 + (lane & 15)) * 1024 + 8 * (lane >> 4);
#pragma unroll 8
          for (int ks = 0; ks < 32; ++ks) acc = mfma16(*(const bf16x8*)(ap + ks * 32), *(const bf16x8*)(bp + ks * 32), acc);
#pragma unroll
          for (int j = 0; j < 4; ++j) spec[(size_t)(row0 + rt * 16 + 4 * (lane >> 4) + j) * 32 + ct * 16 + (lane & 15)] = acc[j]; }
        __syncthreads();
    }
}
template <bool CONV, int NCOLS>
__device__ __forceinline__ void load_chunk(bf16_t* dst, int dstride, const bf16_t* proj, int ld, int tok0, int tpos0, int col0, const float* cw, const float* cb, int cwn, int ch0, float scale) {
    constexpr int NGRP = NCOLS / 8, NT = 128 * NGRP / 512, BT = NT < 4 ? NT : 4;
    const int tid = ltid();
    f32x4 wq[4][2];
    if (CONV) { const int cg0 = ch0 + (tid % NGRP) * 8;
#pragma unroll
        for (int k = 0; k < 3; ++k) { wq[k][0] = *(const f32x4*)(cw + k * cwn + cg0); wq[k][1] = *(const f32x4*)(cw + k * cwn + cg0 + 4); }
        wq[3][0] = *(const f32x4*)(cb + cg0); wq[3][1] = *(const f32x4*)(cb + cg0 + 4); }
#pragma unroll 1
    for (int bt = 0; bt < NT / BT; ++bt) {
        u32x4 u0[BT], u1[BT], u2[BT];
#pragma unroll
        for (int i = 0; i < BT; ++i) { const int task = tid + 512 * (bt * BT + i), r = task / NGRP, cgp = task % NGRP;
            const bf16_t* pp = proj + (size_t)(tok0 + r) * ld + col0 + cgp * 8;
            u1[i] = *(const u32x4*)pp;
            if (CONV) { const bool hp = (tpos0 + r > 0), hn = (tpos0 + r < SEQ - 1); u0[i] = *(const u32x4*)(pp - (hp ? ld : 0)); u2[i] = *(const u32x4*)(pp + (hn ? ld : 0)); } }
#pragma unroll
        for (int i = 0; i < BT; ++i) { const int task = tid + 512 * (bt * BT + i), r = task / NGRP, cgp = task % NGRP; float v[8];
            if (CONV) { float x0[8], x1[8], x2[8]; const float mp = (tpos0 + r > 0) ? 1.0f : 0.0f, mn = (tpos0 + r < SEQ - 1) ? 1.0f : 0.0f;
                unpack8(u0[i], x0); unpack8(u1[i], x1); unpack8(u2[i], x2);
#pragma unroll
                for (int e = 0; e < 8; ++e) { x0[e] *= mp; x2[e] *= mn; }
#pragma unroll
                for (int e = 0; e < 8; ++e) { const float t = wq[3][e >> 2][e & 3] + wq[0][e >> 2][e & 3] * x0[e] + wq[1][e >> 2][e & 3] * x1[e] + wq[2][e >> 2][e & 3] * x2[e]; v[e] = silu_f(t) * scale; }
            } else { unpack8(u1[i], v);
#pragma unroll
                for (int e = 0; e < 8; ++e) v[e] *= scale; }
            *(u32x4*)(dst + r * dstride + cgp * 8) = pack8(v); }
    }
}
template <int STRIDE, int KROWS = 32> __device__ __forceinline__ void tr_frags4(bf16x8 (&f)[4], const bf16_t* tile, int col0) {
    const int lane = ltid() & 63, g = lane >> 4, q = (lane & 15) >> 2, pp = lane & 3;
    const unsigned a = (unsigned)(size_t)(tile + (8 * g + q) * STRIDE + col0) + 8u * pp;
    u32x2 r0, r1, r2, r3, r4, r5, r6, r7;
    asm volatile("ds_read_b64_tr_b16 %0, %8 offset:%9\n\tds_read_b64_tr_b16 %1, %8 offset:%10\n\tds_read_b64_tr_b16 %2, %8 offset:%11\n\tds_read_b64_tr_b16 %3, %8 offset:%12\n\t"
                 "ds_read_b64_tr_b16 %4, %8 offset:%13\n\tds_read_b64_tr_b16 %5, %8 offset:%14\n\tds_read_b64_tr_b16 %6, %8 offset:%15\n\tds_read_b64_tr_b16 %7, %8 offset:%16\n\ts_waitcnt lgkmcnt(0)"
                 : "=&v"(r0), "=&v"(r1), "=&v"(r2), "=&v"(r3), "=&v"(r4), "=&v"(r5), "=&v"(r6), "=&v"(r7)
                 : "v"(a), "i"(0 * STRIDE * 2), "i"(4 * STRIDE * 2), "i"(KROWS * STRIDE * 2), "i"((KROWS + 4) * STRIDE * 2), "i"(2 * KROWS * STRIDE * 2), "i"((2 * KROWS + 4) * STRIDE * 2), "i"(3 * KROWS * STRIDE * 2), "i"((3 * KROWS + 4) * STRIDE * 2) : "memory");
    f[0] = as_bf16x8((u32x4){r0.x, r0.y, r1.x, r1.y}); f[1] = as_bf16x8((u32x4){r2.x, r2.y, r3.x, r3.y}); f[2] = as_bf16x8((u32x4){r4.x, r4.y, r5.x, r5.y}); f[3] = as_bf16x8((u32x4){r6.x, r6.y, r7.x, r7.y});
}
__device__ __forceinline__ bf16x8 gather8(const bf16_t* base, int stride) {
    bf16x8 r;
#pragma unroll
    for (int e = 0; e < 8; ++e) r[e] = (short)base[e * stride];
    return r;
}
__device__ __forceinline__ void lds_transpose(const bf16_t* src, int sstride, bf16_t* dst, int ncols) {
    for (int task = ltid(); task < 16 * ncols; task += 512) { const int c = task % ncols, rg = task / ncols; u32x4 w;
        const bf16_t* sp = src + (rg * 8) * sstride + c;
        w.x = (unsigned)sp[0] | ((unsigned)sp[sstride] << 16); w.y = (unsigned)sp[2 * sstride] | ((unsigned)sp[3 * sstride] << 16);
        w.z = (unsigned)sp[4 * sstride] | ((unsigned)sp[5 * sstride] << 16); w.w = (unsigned)sp[6 * sstride] | ((unsigned)sp[7 * sstride] << 16);
        *(u32x4*)(dst + c * 136 + rg * 8) = w; }
}
template <int MODE>
__device__ __forceinline__ void decay_prep(KPR p, int layer, int hdl, int headg, int dir, int tok0, float* sE, float* sWv, float* sWgt, float* sTot) {
    const int lane = ltid() & 63; const float* spec = (const float*)(p.ws + WS_SPEC);
    const int u0 = 2 * lane, u1 = u0 + 1, s0 = dir ? 127 - u0 : u0, s1 = dir ? 127 - u1 : u1;
    float a0, a1, w0, w1;
    if (MODE == 0) {
        const float bias = p.in[I_MBDTB][layer * 16 + dir * 8 + headg], A = -__expf(p.in[I_MBALOG][layer * 16 + dir * 8 + headg]);
        const float r0 = spec[(size_t)(tok0 + s0) * 32 + dir * 8 + headg] + bias, r1 = spec[(size_t)(tok0 + s1) * 32 + dir * 8 + headg] + bias;
        w0 = r0 > 20.f ? r0 : log1pf(__expf(r0)); w1 = r1 > 20.f ? r1 : log1pf(__expf(r1)); a0 = w0 * A; a1 = w1 * A;
    } else {
        const float bi = p.in[I_MLGB][layer * 16 + dir * 8 + headg], bf = p.in[I_MLGB][layer * 16 + dir * 8 + 4 + headg];
        const float i0 = spec[(size_t)(tok0 + s0) * 32 + 16 + dir * 8 + headg] + bi, i1 = spec[(size_t)(tok0 + s1) * 32 + 16 + dir * 8 + headg] + bi;
        const float f0 = spec[(size_t)(tok0 + s0) * 32 + 16 + dir * 8 + 4 + headg] + bf, f1 = spec[(size_t)(tok0 + s1) * 32 + 16 + dir * 8 + 4 + headg] + bf;
        w0 = __expf(i0); w1 = __expf(i1);
        a0 = fminf(f0, 0.f) - log1pf(__expf(-fabsf(f0))); a1 = fminf(f1, 0.f) - log1pf(__expf(-fabsf(f1)));
    }
    const float pr = a0 + a1; float incl = pr;
#pragma unroll
    for (int d = 1; d < 64; d <<= 1) { const float t = __shfl_up(incl, d); if (lane >= d) incl += t; }
    const float e0 = incl - pr + a0, e1 = incl, tot = __shfl(incl, 63);
    sE[hdl * 128 + s0] = e0; sE[hdl * 128 + s1] = e1; sWv[hdl * 128 + s0] = w0; sWv[hdl * 128 + s1] = w1;
    if (sWgt) { sWgt[hdl * 128 + s0] = __expf(tot - e0) * w0; sWgt[hdl * 128 + s1] = __expf(tot - e1) * w1; if (lane == 0) sTot[hdl] = tot; }
}

template <int MODE> struct SsdCfg;
template <> struct SsdCfg<0> { static constexpr int NH = 4, PT = 4, PP = 64, NHT = 8, LD = 1536, NITEM = 512, PTO = 4; };
template <> struct SsdCfg<1> { static constexpr int NH = 1, PT = 9, PP = 144, NHT = 4, LD = 2560, NITEM = 1024, PTO = 8; };

template <int MODE>
__device__ __forceinline__ void ssd_m1(KPR p, int layer, unsigned char* smem) {
    typedef SsdCfg<MODE> C;
    constexpr int XS = (MODE == 0) ? 264 : 152;
    bf16_t* sBm = (bf16_t*)smem; bf16_t* sX = sBm + 128 * 136;
    float* sE = (float*)(smem + 34816 + 67584); float* sWv = sE + 1024; float* sWgt = sWv + 1024; float* sTot = sWgt + 1024;
    const bf16_t* proj = (const bf16_t*)(p.ws + WS_PROJ); bf16_t* ST = (bf16_t*)(p.ws + WS_AUX); float* atot = (float*)(p.ws + WS_ATOT);
    const int tid = ltid(), wid = tid >> 6, lane = tid & 63, lr = lane & 15, lq = lane >> 4;
    const float* cw = p.in[MODE == 0 ? I_MBCW : I_MLCW] + layer * 3 * 1024; const float* cb = p.in[MODE == 0 ? I_MBCB : I_MLCB] + layer * 1024;
    for (int it = blockIdx.x; it < C::NITEM; it += gridDim.x) {
        int g, c, b;
        if (MODE == 0) { g = it & 1; c = (it >> 1) & 63; b = it >> 7; } else { g = it & 3; c = (it >> 2) & 63; b = it >> 8; }
        const int tok0 = b * SEQ + c * 128, tpos0 = c * 128;
        load_chunk<true, 128>(sBm, 136, proj, C::LD, tok0, tpos0, 512 + g * 128, cw, cb, 1024, 512 + g * 128, MODE == 0 ? 1.0f : 0.08838834764831845f);
        if (MODE == 0) { load_chunk<true, 128>(sX, XS, proj, C::LD, tok0, tpos0, g * 256, cw, cb, 1024, g * 256, 1.0f); load_chunk<true, 128>(sX + 128, XS, proj, C::LD, tok0, tpos0, g * 256 + 128, cw, cb, 1024, g * 256 + 128, 1.0f); }
        else { load_chunk<false, 128>(sX, XS, proj, C::LD, tok0, tpos0, 1024 + g * 128, cw, cb, 1024, 0, 1.0f);
            for (int idx = tid; idx < 128 * 16; idx += 512) sX[(idx >> 4) * XS + 128 + (idx & 15)] = ((idx & 15) == 0) ? (bf16_t)0x3F80 : (bf16_t)0; }
        if (wid < 2 * C::NH) { const int hl = wid >> 1, dir = wid & 1, headg = (MODE == 0) ? g * 4 + hl : g; decay_prep<MODE>(p, layer, wid, headg, dir, tok0, sE, sWv, sWgt, sTot); }
        __syncthreads();
        for (int t = wid; t < C::NH * 2 * C::PT; t += 8) {
            const int hdl = t % (2 * C::NH), pt = t / (2 * C::NH), hl = hdl >> 1, dir = hdl & 1, headg = (MODE == 0) ? g * 4 + hl : g;
            bf16x8 bfr[4]; tr_frags4<XS>(bfr, sX, hl * C::PP + pt * 16);
#pragma unroll
            for (int ks = 0; ks < 4; ++ks) { const int sb = ks * 32 + 8 * lq; float v[8]; union { bf16x8 b; u32x4 u; } cv; cv.b = bfr[ks]; unpack8(cv.u, v);
                const f32x4 w0 = *(const f32x4*)(sWgt + hdl * 128 + sb), w1 = *(const f32x4*)(sWgt + hdl * 128 + sb + 4);
                v[0] *= w0[0]; v[1] *= w0[1]; v[2] *= w0[2]; v[3] *= w0[3]; v[4] *= w1[0]; v[5] *= w1[1]; v[6] *= w1[2]; v[7] *= w1[3];
                bfr[ks] = as_bf16x8(pack8(v)); }
            const int seq = (b * C::NHT + headg) * 2 + dir;
            bf16_t* outp = ST + (size_t)(seq * 64 + c) * C::PP * 128;
#pragma unroll
            for (int nt = 0; nt < 8; ++nt) { f32x4 acc = {0.f, 0.f, 0.f, 0.f}; bf16x8 af[4]; tr_frags4<136>(af, sBm, nt * 16);
#pragma unroll
                for (int ks = 0; ks < 4; ++ks) acc = mfma16(af[ks], bfr[ks], acc);
                u32x2 o; o.x = pk2(acc[0], acc[1]); o.y = pk2(acc[2], acc[3]);
                *(u32x2*)(outp + (pt * 16 + lr) * 128 + nt * 16 + 4 * lq) = o; }
        }
        if (tid < 2 * C::NH) { const int hl = tid >> 1, dir = tid & 1, headg = (MODE == 0) ? g * 4 + hl : g; atot[((b * C::NHT + headg) * 2 + dir) * 64 + c] = sTot[tid]; }
        __syncthreads();
    }
}
template <int MODE>
__device__ __forceinline__ void ssd_m2(KPR p) {
    typedef SsdCfg<MODE> C;
    bf16_t* ST = (bf16_t*)(p.ws + WS_AUX); const float* atot = (const float*)(p.ws + WS_ATOT);
    constexpr int PER = C::PP * 128 / 4, NSEQ = 4 * C::NHT * 2, TOTAL = NSEQ * PER;
    for (int task = blockIdx.x * 512 + ltid(); task < TOTAL; task += gridDim.x * 512) {
        const int seq = task / PER, off = (task % PER) * 4, dir = seq & 1;
        float h0 = 0.f, h1 = 0.f, h2 = 0.f, h3 = 0.f;
#pragma unroll 1
        for (int cb = 0; cb < 64; cb += 16) {
            u32x2 sv[16]; float dv[16];
#pragma unroll
            for (int i = 0; i < 16; ++i) { const int c = dir ? 63 - (cb + i) : (cb + i); sv[i] = *(const u32x2*)(ST + (size_t)(seq * 64 + c) * C::PP * 128 + off); dv[i] = atot[seq * 64 + c]; }
#pragma unroll
            for (int i = 0; i < 16; ++i) { const int c = dir ? 63 - (cb + i) : (cb + i); const float d = __expf(dv[i]);
                u32x2 o; o.x = pk2(h0, h1); o.y = pk2(h2, h3); *(u32x2*)(ST + (size_t)(seq * 64 + c) * C::PP * 128 + off) = o;
                h0 = h0 * d + __uint_as_float(sv[i].x << 16); h1 = h1 * d + __uint_as_float(sv[i].x & 0xffff0000u);
                h2 = h2 * d + __uint_as_float(sv[i].y << 16); h3 = h3 * d + __uint_as_float(sv[i].y & 0xffff0000u); }
        }
    }
}
template <int MODE>
__device__ __forceinline__ void ssd_m3(KPR p, int layer, unsigned char* smem) {
    typedef SsdCfg<MODE> C;
    constexpr int XS = (MODE == 0) ? 72 : 152;
    bf16_t* sC = (bf16_t*)smem; bf16_t* sB = (bf16_t*)(smem + 34816); bf16_t* sXT = (bf16_t*)(smem + 73984); bf16_t* sG = (bf16_t*)(smem + 113152);
    float* sE = (float*)(smem + 147968); float* sWv = sE + 1024;
    const bf16_t* proj = (const bf16_t*)(p.ws + WS_PROJ); const bf16_t* ST = (const bf16_t*)(p.ws + WS_AUX); bf16_t* Y = (bf16_t*)(p.ws + WS_Y);
    const int tid = ltid(), wid = tid >> 6, lane = tid & 63, lr = lane & 15, lq = lane >> 4;
    const float* cw = p.in[MODE == 0 ? I_MBCW : I_MLCW] + layer * 3 * 1024; const float* cb = p.in[MODE == 0 ? I_MBCB : I_MLCB] + layer * 1024;
    for (int it = blockIdx.x; it < C::NITEM; it += gridDim.x) {
        int g, c, b;
        if (MODE == 0) { g = it & 1; c = (it >> 1) & 63; b = it >> 7; } else { g = it & 3; c = (it >> 2) & 63; b = it >> 8; }
        const int tok0 = b * SEQ + c * 128, tpos0 = c * 128;
        if (MODE == 0) {
            load_chunk<true, 128>(sC, 136, proj, C::LD, tok0, tpos0, 768 + g * 128, cw, cb, 1024, 768 + g * 128, 1.0f);
            load_chunk<true, 128>(sB, 136, proj, C::LD, tok0, tpos0, 512 + g * 128, cw, cb, 1024, 512 + g * 128, 1.0f);
        } else {
            load_chunk<true, 128>(sC, 136, proj, C::LD, tok0, tpos0, g * 128, cw, cb, 1024, g * 128, 1.0f);
            load_chunk<true, 128>(sB, 136, proj, C::LD, tok0, tpos0, 512 + g * 128, cw, cb, 1024, 512 + g * 128, 0.08838834764831845f);
        }
        if (MODE == 1) { load_chunk<false, 128>(sXT, 152, proj, C::LD, tok0, tpos0, 1024 + g * 128, cw, cb, 1024, 0, 1.0f);
            for (int idx = tid; idx < 128 * 16; idx += 512) sXT[(idx >> 4) * 152 + 128 + (idx & 15)] = ((idx & 15) == 0) ? (bf16_t)0x3F80 : (bf16_t)0; }
        if (wid < 2 * C::NH) { const int hl = wid >> 1, dir = wid & 1, headg = (MODE == 0) ? g * 4 + hl : g; decay_prep<MODE>(p, layer, wid, headg, dir, tok0, sE, sWv, nullptr, nullptr); }
        __syncthreads();
        f32x4 accG[8];
#pragma unroll
        for (int st = 0; st < 8; ++st) { accG[st] = (f32x4){0.f, 0.f, 0.f, 0.f};
#pragma unroll
            for (int ks = 0; ks < 4; ++ks) accG[st] = mfma16(*(const bf16x8*)(sC + (16 * wid + lr) * 136 + ks * 32 + 8 * lq), *(const bf16x8*)(sB + (st * 16 + lr) * 136 + ks * 32 + 8 * lq), accG[st]); }
        __syncthreads();
        f32x4 outv[C::PTO]; float ssr[4] = {0.f, 0.f, 0.f, 0.f};
#pragma unroll 1
        for (int hl = 0; hl < C::NH; ++hl) {
            const int headg = (MODE == 0) ? g * 4 + hl : g;
#pragma unroll
            for (int i = 0; i < C::PTO; ++i) outv[i] = (f32x4){0.f, 0.f, 0.f, 0.f};
            if (MODE == 0) { load_chunk<true, 64>(sG, 72, proj, C::LD, tok0, tpos0, headg * 64, cw, cb, 1024, headg * 64, 1.0f); __syncthreads(); lds_transpose(sG, 72, sXT, 64); __syncthreads(); }

#pragma unroll 1
            for (int dir = 0; dir < 2; ++dir) {
                const int hdl = hl * 2 + dir, seq = (b * C::NHT + headg) * 2 + dir;
                const bf16_t* Hs = ST + (size_t)(seq * 64 + c) * C::PP * 128;
                { constexpr int NHT_T = (C::PP * 16 + 511) / 512; u32x4 hv[NHT_T];
#pragma unroll
                  for (int i = 0; i < NHT_T; ++i) { const int task = tid + 512 * i, tk = task < C::PP * 16 ? task : 0; hv[i] = *(const u32x4*)(Hs + (tk >> 4) * 128 + (tk & 15) * 8); }
#pragma unroll
                  for (int i = 0; i < NHT_T; ++i) { const int task = tid + 512 * i; if (task < C::PP * 16) *(u32x4*)(sB + (task >> 4) * 136 + (task & 15) * 8) = hv[i]; } }
                float et[4];
#pragma unroll
                for (int j = 0; j < 4; ++j) et[j] = sE[hdl * 128 + 16 * wid + 4 * lq + j];
#pragma unroll
                for (int st = 0; st < 8; ++st) { const int s = st * 16 + lr; const float es = sE[hdl * 128 + s], ws = sWv[hdl * 128 + s];
#pragma unroll
                    for (int j = 0; j < 4; ++j) { const int t = 16 * wid + 4 * lq + j; const bool valid = dir ? (s >= t) : (s <= t);
                        const float val = valid ? accG[st][j] * __expf(fminf(et[j] - es, 0.f)) * ws : 0.f; sG[t * 136 + s] = f2bf(val); } }
                __syncthreads();
                f32x4 acc[C::PT];
#pragma unroll
                for (int pt = 0; pt < C::PT; ++pt) acc[pt] = (f32x4){0.f, 0.f, 0.f, 0.f};
#pragma unroll
                for (int ks = 0; ks < 4; ++ks) { const bf16x8 a2 = *(const bf16x8*)(sC + (16 * wid + lr) * 136 + ks * 32 + 8 * lq);
#pragma unroll
                    for (int pt = 0; pt < C::PT; ++pt) acc[pt] = mfma16(a2, *(const bf16x8*)(sB + (pt * 16 + lr) * 136 + ks * 32 + 8 * lq), acc[pt]); }
#pragma unroll
                for (int j = 0; j < 4; ++j) { const float ex = __expf(et[j]);
#pragma unroll
                    for (int pt = 0; pt < C::PT; ++pt) acc[pt][j] *= ex; }
                { bf16x8 ag[4];
#pragma unroll
                  for (int ks = 0; ks < 4; ++ks) ag[ks] = *(const bf16x8*)(sG + (16 * wid + lr) * 136 + ks * 32 + 8 * lq);
#pragma unroll
                  for (int pt = 0; pt < C::PT; ++pt) { bf16x8 xb[4];
                      if (MODE == 1) tr_frags4<152>(xb, sXT, pt * 16);
                      else {
#pragma unroll
                          for (int ks = 0; ks < 4; ++ks) xb[ks] = *(const bf16x8*)(sXT + (pt * 16 + lr) * 136 + ks * 32 + 8 * lq); }
#pragma unroll
                      for (int ks = 0; ks < 4; ++ks) acc[pt] = mfma16(ag[ks], xb[ks], acc[pt]); } }
#pragma unroll
                for (int j = 0; j < 4; ++j) {
                    if (MODE == 0) {
#pragma unroll
                        for (int pt = 0; pt < 4; ++pt) outv[pt][j] += acc[pt][j];
                    } else {
                        float den = acc[C::PT - 1][j]; den = __shfl(den, lane & 48); const float inv = rcp_f(fmaxf(fabsf(den), 1.0f));
#pragma unroll
                        for (int pt = 0; pt < 8; ++pt) outv[pt][j] += acc[pt][j] * inv;
                    } }
                __syncthreads();
            }
            if (MODE == 0) { const float D = p.in[I_MBD][layer * 8 + headg];
#pragma unroll
                for (int pt = 0; pt < 4; ++pt)
#pragma unroll
                    for (int j = 0; j < 4; ++j) outv[pt][j] += D * bf2f(sXT[(pt * 16 + lr) * 136 + 16 * wid + 4 * lq + j]);
#pragma unroll
                for (int j = 0; j < 4; ++j) { const size_t tok = (size_t)tok0 + 16 * wid + 4 * lq + j;
#pragma unroll
                    for (int pt = 0; pt < 4; ++pt) { const int col = hl * 64 + pt * 16 + lr; const float z = bf2f(proj[tok * 1536 + 1024 + g * 256 + col]); const float v = outv[pt][j] * silu_f(z);
                        ssr[j] += v * v; Y[tok * 2048 + 512 + g * 256 + col] = f2bf(v); } }
                __syncthreads(); }
        }
        if (MODE == 0) {
            float* sR = sE;
#pragma unroll
            for (int j = 0; j < 4; ++j) { float ss = ssr[j];
#pragma unroll
                for (int d = 1; d < 16; d <<= 1) ss += __shfl_xor(ss, d);
                if (lr == 0) sR[16 * wid + 4 * lq + j] = rsqrtf(ss * (1.0f / 256.0f) + 1e-6f); }
            __syncthreads();
            for (int task = tid; task < 128 * 32; task += 512) { const int r = task >> 5, cgp = task & 31; bf16_t* yp = Y + ((size_t)tok0 + r) * 2048 + 512 + g * 256 + cgp * 8;
                float v[8]; unpack8(*(const u32x4*)yp, v); const float rstd = sR[r]; const float* nw = p.in[I_MBNW] + layer * 512 + g * 256 + cgp * 8;
#pragma unroll
                for (int e = 0; e < 8; ++e) v[e] *= rstd * nw[e];
                *(u32x4*)yp = pack8(v); }
        } else {
            float* sH = (float*)smem;
#pragma unroll
            for (int i = 0; i < 8; ++i)
#pragma unroll
                for (int j = 0; j < 4; ++j) sH[(16 * wid + 4 * lq + j) * 132 + i * 16 + lr] = outv[i][j];
            asm volatile("s_waitcnt lgkmcnt(0)" ::: "memory");
            { u32x4 ou[4], zu[4];
#pragma unroll
              for (int i = 0; i < 4; ++i) { const int task = lane + 64 * i, row = 16 * wid + (task >> 4), cgp = task & 15; const bf16_t* pp = proj + ((size_t)tok0 + row) * 2560 + 1536 + g * 128 + cgp * 8;
                  ou[i] = *(const u32x4*)pp; zu[i] = *(const u32x4*)(pp + 512); }
              const f32x4 nw0 = *(const f32x4*)(p.in[I_MLNW] + layer * 512 + g * 128 + (lane & 15) * 8), nw1 = *(const f32x4*)(p.in[I_MLNW] + layer * 512 + g * 128 + (lane & 15) * 8 + 4);
#pragma unroll
              for (int i = 0; i < 4; ++i) { const int task = lane + 64 * i, row = 16 * wid + (task >> 4), cgp = task & 15; float o[8], z[8], v[8]; unpack8(ou[i], o); unpack8(zu[i], z);
                  const f32x4 h0 = *(const f32x4*)(sH + row * 132 + cgp * 8), h1 = *(const f32x4*)(sH + row * 132 + cgp * 8 + 4); float ss = 0.f;
#pragma unroll
                  for (int e = 0; e < 8; ++e) { v[e] = (e < 4 ? h0[e] : h1[e - 4]) * sigmoid_f(o[e]); ss += v[e] * v[e]; }
#pragma unroll
                  for (int d = 1; d < 16; d <<= 1) ss += __shfl_xor(ss, d);
                  const float rstd = rsqrtf(ss * (1.0f / 128.0f) + 1e-6f);
#pragma unroll
                  for (int e = 0; e < 8; ++e) v[e] *= rstd * (e < 4 ? nw0[e] : nw1[e - 4]) * silu_f(z[e]);
                  *(u32x4*)(Y + ((size_t)tok0 + row) * 2048 + 1024 + g * 128 + cgp * 8) = pack8(v); } }
        }
        __syncthreads();
    }
}
__device__ __forceinline__ void ssd_m3_mamba(KPR p, int layer, unsigned char* smem) {
    bf16_t* sC = (bf16_t*)smem; bf16_t* sB = (bf16_t*)(smem + 34816); bf16_t* sXT = (bf16_t*)(smem + 73984); bf16_t* sG = (bf16_t*)(smem + 113152);
    float* sE = (float*)(smem + 147968); float* sWv = sE + 1024;
    const bf16_t* proj = (const bf16_t*)(p.ws + WS_PROJ); const bf16_t* ST = (const bf16_t*)(p.ws + WS_AUX); bf16_t* Y = (bf16_t*)(p.ws + WS_Y);
    const int tid = ltid(), wid = tid >> 6, lane = tid & 63, lr = lane & 15, lq = lane >> 4;
    const float* cw = p.in[I_MBCW] + layer * 3 * 1024; const float* cb = p.in[I_MBCB] + layer * 1024;
    for (int it = blockIdx.x; it < 512; it += gridDim.x) {
        const int g = it & 1, c = (it >> 1) & 63, b = it >> 7, tok0 = b * SEQ + c * 128, tpos0 = c * 128;
        load_chunk<true, 128>(sC, 136, proj, 1536, tok0, tpos0, 768 + g * 128, cw, cb, 1024, 768 + g * 128, 1.0f);
        load_chunk<true, 128>(sB, 136, proj, 1536, tok0, tpos0, 512 + g * 128, cw, cb, 1024, 512 + g * 128, 1.0f);
        { const int hl = wid >> 1, dir = wid & 1; decay_prep<0>(p, layer, wid, g * 4 + hl, dir, tok0, sE, sWv, nullptr, nullptr); }
        __syncthreads();
        f32x4 accG[8];
#pragma unroll
        for (int st = 0; st < 8; ++st) { accG[st] = (f32x4){0.f, 0.f, 0.f, 0.f};
#pragma unroll
            for (int ks = 0; ks < 4; ++ks) accG[st] = mfma16(*(const bf16x8*)(sC + (16 * wid + lr) * 136 + ks * 32 + 8 * lq), *(const bf16x8*)(sB + (st * 16 + lr) * 136 + ks * 32 + 8 * lq), accG[st]); }
        __syncthreads();
        float ssr[4] = {0.f, 0.f, 0.f, 0.f};
#pragma unroll 1
        for (int hl = 0; hl < 4; ++hl) {
            const int headg = g * 4 + hl;
            load_chunk<true, 64>(sG, 72, proj, 1536, tok0, tpos0, headg * 64, cw, cb, 1024, headg * 64, 1.0f);
            { const bf16_t* Hf = ST + (size_t)(((b * 8 + headg) * 2) * 64 + c) * 8192; const bf16_t* Hb = ST + (size_t)(((b * 8 + headg) * 2 + 1) * 64 + c) * 8192;
              u32x4 hv[4];
#pragma unroll
              for (int i = 0; i < 4; ++i) { const int task = tid + 512 * i, row = task >> 4, cgp = task & 15; const bf16_t* src = (row < 64) ? (Hf + row * 128) : (Hb + (row - 64) * 128); hv[i] = *(const u32x4*)(src + cgp * 8); }
              load_chunk<true, 64>(sXT, 72, proj, 1536, tok0, tpos0, headg * 64, cw, cb, 1024, headg * 64, 1.0f);
#pragma unroll
              for (int i = 0; i < 4; ++i) { const int task = tid + 512 * i; *(u32x4*)(sB + (task >> 4) * 136 + (task & 15) * 8) = hv[i]; } }
            float etf[4], etb[4];
#pragma unroll
            for (int j = 0; j < 4; ++j) { etf[j] = sE[(hl * 2) * 128 + 16 * wid + 4 * lq + j]; etb[j] = sE[(hl * 2 + 1) * 128 + 16 * wid + 4 * lq + j]; }
#pragma unroll
            for (int st = 0; st < 8; ++st) { const int s = st * 16 + lr; const float esf = sE[(hl * 2) * 128 + s], wsf = sWv[(hl * 2) * 128 + s], esb = sE[(hl * 2 + 1) * 128 + s], wsb = sWv[(hl * 2 + 1) * 128 + s];
#pragma unroll
                for (int j = 0; j < 4; ++j) { const int t = 16 * wid + 4 * lq + j;
                    const float df = (s <= t) ? __expf(fminf(etf[j] - esf, 0.f)) * wsf : 0.f, db = (s >= t) ? __expf(fminf(etb[j] - esb, 0.f)) * wsb : 0.f;
                    sG[t * 136 + s] = f2bf(accG[st][j] * (df + db)); } }
            __syncthreads();
            f32x4 accd[4], accf[4], accb[4];
#pragma unroll
            for (int pt = 0; pt < 4; ++pt) { accd[pt] = (f32x4){0.f, 0.f, 0.f, 0.f}; accf[pt] = accd[pt]; accb[pt] = accd[pt]; }
            { bf16x8 ag[4], ac[4];
#pragma unroll
              for (int ks = 0; ks < 4; ++ks) { ag[ks] = *(const bf16x8*)(sG + (16 * wid + lr) * 136 + ks * 32 + 8 * lq); ac[ks] = *(const bf16x8*)(sC + (16 * wid + lr) * 136 + ks * 32 + 8 * lq); }
#pragma unroll
              for (int pt = 0; pt < 4; ++pt) { bf16x8 xb[4]; tr_frags4<72>(xb, sXT, pt * 16);
#pragma unroll
                  for (int ks = 0; ks < 4; ++ks) { accd[pt] = mfma16(ag[ks], xb[ks], accd[pt]);
                      accf[pt] = mfma16(ac[ks], *(const bf16x8*)(sB + (pt * 16 + lr) * 136 + ks * 32 + 8 * lq), accf[pt]);
                      accb[pt] = mfma16(ac[ks], *(const bf16x8*)(sB + (64 + pt * 16 + lr) * 136 + ks * 32 + 8 * lq), accb[pt]); } } }
            const float D = p.in[I_MBD][layer * 8 + headg];
            bf16_t zraw[4][4];
#pragma unroll
            for (int pt = 0; pt < 4; ++pt)
#pragma unroll
                for (int j = 0; j < 4; ++j) zraw[pt][j] = proj[((size_t)tok0 + 16 * wid + 4 * lq + j) * 1536 + 1024 + g * 256 + hl * 64 + pt * 16 + lr];
#pragma unroll
            for (int pt = 0; pt < 4; ++pt) { float xv[4];
#pragma unroll
                for (int j = 0; j < 4; ++j) xv[j] = bf2f(sXT[(16 * wid + 4 * lq + j) * 72 + pt * 16 + lr]);
#pragma unroll
                for (int j = 0; j < 4; ++j) { const size_t tok = (size_t)tok0 + 16 * wid + 4 * lq + j; const int col = hl * 64 + pt * 16 + lr;
                    const float yv = accd[pt][j] + __expf(etf[j]) * accf[pt][j] + __expf(etb[j]) * accb[pt][j] + D * xv[j];
                    const float z = bf2f(zraw[pt][j]); const float v = yv * silu_f(z);
                    ssr[j] += v * v; Y[tok * 2048 + 512 + g * 256 + col] = f2bf(v); } }
            __syncthreads();
        }
        float* sR = sE;
#pragma unroll
        for (int j = 0; j < 4; ++j) { float ss = ssr[j];
#pragma unroll
            for (int d = 1; d < 16; d <<= 1) ss += __shfl_xor(ss, d);
            if (lr == 0) sR[16 * wid + 4 * lq + j] = rsqrtf(ss * (1.0f / 256.0f) + 1e-6f); }
        __syncthreads();
#pragma unroll 1
        for (int bt = 0; bt < 2; ++bt) { u32x4 yv[4];
#pragma unroll
            for (int i = 0; i < 4; ++i) { const int task = tid + 512 * (bt * 4 + i), r = task >> 5, cgp = task & 31; yv[i] = *(const u32x4*)(Y + ((size_t)tok0 + r) * 2048 + 512 + g * 256 + cgp * 8); }
#pragma unroll
            for (int i = 0; i < 4; ++i) { const int task = tid + 512 * (bt * 4 + i), r = task >> 5, cgp = task & 31; float v[8]; unpack8(yv[i], v); const float rstd = sR[r]; const float* nw = p.in[I_MBNW] + layer * 512 + g * 256 + cgp * 8;
#pragma unroll
                for (int e = 0; e < 8; ++e) v[e] *= rstd * nw[e];
                *(u32x4*)(Y + ((size_t)tok0 + r) * 2048 + 512 + g * 256 + cgp * 8) = pack8(v); } }
        __syncthreads();
    }
}
__device__ __forceinline__ void na_phase(KPR p, int layer, unsigned char* smem) {
    bf16_t* sV = (bf16_t*)smem;
    bf16_t* sP = (bf16_t*)(smem + 82944);
    float* sRpb = (float*)(smem + 82944 + 67584);
    const bf16_t* proj = (const bf16_t*)(p.ws + WS_PROJ); bf16_t* Y = (bf16_t*)(p.ws + WS_Y);
    const float* qnw = p.in[I_NAQN] + layer * 64; const float* knw = p.in[I_NAKN] + layer * 64; const float* rpb = p.in[I_NARPB] + layer * 8 * 15 * 31;
    const int tid = ltid(), wid = tid >> 6, lane = tid & 63, lr = lane & 15, lq = lane >> 4;
    bf16_t* sPw = sP + wid * 16 * 264;
    for (int it = blockIdx.x; it < 2048; it += gridDim.x) {
        const int h = it & 7, rp = (it >> 3) & 63, b = it >> 9, r0 = 2 * rp, base = clampi(r0 - 4, 0, 120);
        const int r = r0 + (wid >> 2), qt = wid & 3, rs = clampi(r - 4, 0, 120), cbase = clampi(16 * qt - 8, 0, 32);
        u32x4 ka0[4], ka1[4], uq0, uq1;
        auto load_kgroup = [&](u32x4 (&k0)[4], u32x4 (&k1)[4], int kg) {
#pragma unroll
            for (int kk = 0; kk < 4; ++kk) { const int kt = kg * 4 + kk, i = kt >> 1, cc0 = (kt & 1) * 16, kc = cbase + cc0 + lr, kr = rs + i;
                const bf16_t* kp = proj + (size_t)(b * SEQ + kr * 64 + kc) * 2048 + 512 + h * 64 + 8 * lq; k0[kk] = *(const u32x4*)kp; k1[kk] = *(const u32x4*)(kp + 32); } };
        { u32x4 vv[9];
#pragma unroll
          for (int i = 0; i < 9; ++i) { const int task = tid + 512 * i, kk = task >> 3, dg = task & 7; int row = base + (kk >> 6); row = row < 128 ? row : 127;
              vv[i] = *(const u32x4*)(proj + (size_t)(b * SEQ + row * 64 + (kk & 63)) * 2048 + 1024 + h * 64 + dg * 8); }
          { const bf16_t* qp = proj + (size_t)(b * SEQ + r * 64 + 16 * qt + lr) * 2048 + h * 64 + 8 * lq; uq0 = *(const u32x4*)qp; uq1 = *(const u32x4*)(qp + 32); }
          load_kgroup(ka0, ka1, 0);
#pragma unroll
          for (int i = 0; i < 9; ++i) { const int task = tid + 512 * i, kk = task >> 3, dg = task & 7; *(u32x4*)(sV + kk * 72 + dg * 8) = vv[i]; } }
        if (tid < 465) sRpb[tid] = rpb[h * 465 + tid];
        __syncthreads();
        u32x4 kb0[4], kb1[4]; load_kgroup(kb0, kb1, 1);
        bf16x8 qf[2];
        { float v0[8], v1[8]; unpack8(uq0, v0); unpack8(uq1, v1);
          float ss = 0.f;
#pragma unroll
          for (int e = 0; e < 8; ++e) ss += v0[e] * v0[e] + v1[e] * v1[e];
          ss += __shfl_xor(ss, 16); ss += __shfl_xor(ss, 32); const float rstd = rsqrtf(ss * (1.0f / 64.0f) + 1e-6f) * 0.125f;
#pragma unroll
          for (int e = 0; e < 8; ++e) { v0[e] *= rstd * qnw[8 * lq + e] * knw[8 * lq + e]; v1[e] *= rstd * qnw[32 + 8 * lq + e] * knw[32 + 8 * lq + e]; }
          qf[0] = as_bf16x8(pack8(v0)); qf[1] = as_bf16x8(pack8(v1)); }
        f32x4 S[16];
        bool vld[2][4]; int bof[2][4];
#pragma unroll
        for (int par = 0; par < 2; ++par)
#pragma unroll
            for (int j = 0; j < 4; ++j) { const int cq = 16 * qt + 4 * lq + j, st = clampi(cq - 8, 0, 48), kc = cbase + par * 16 + lr; vld[par][j] = (kc >= st) && (kc < st + 16);
                bof[par][j] = vld[par][j] ? (rs - r + 7) * 31 + (kc - cq + 15) : 0; }
        auto score_kgroup = [&](const u32x4 (&k0)[4], const u32x4 (&k1)[4], int kg) {
#pragma unroll
            for (int kk = 0; kk < 4; ++kk) { const int kt = kg * 4 + kk, i = kt >> 1, par = kt & 1;
                float v0[8], v1[8]; unpack8(k0[kk], v0); unpack8(k1[kk], v1); float ss = 0.f;
#pragma unroll
                for (int e = 0; e < 8; ++e) ss += v0[e] * v0[e] + v1[e] * v1[e];
                ss += __shfl_xor(ss, 16); ss += __shfl_xor(ss, 32); const float rstd = rsqrtf(ss * (1.0f / 64.0f) + 1e-6f);
                f32x4 acc = {0.f, 0.f, 0.f, 0.f}; acc = mfma16(qf[0], as_bf16x8(k0[kk]), acc); acc = mfma16(qf[1], as_bf16x8(k1[kk]), acc);
#pragma unroll
                for (int j = 0; j < 4; ++j) S[kt][j] = vld[par][j] ? acc[j] * rstd + sRpb[bof[par][j] + 31 * i] : -1e30f; } };
        score_kgroup(ka0, ka1, 0); load_kgroup(ka0, ka1, 2);
        score_kgroup(kb0, kb1, 1); load_kgroup(kb0, kb1, 3);
        score_kgroup(ka0, ka1, 2);
        score_kgroup(kb0, kb1, 3);
        float inv[4];
#pragma unroll
        for (int j = 0; j < 4; ++j) { float m = S[0][j];
#pragma unroll
            for (int kt = 1; kt < 16; ++kt) m = fmaxf(m, S[kt][j]);
#pragma unroll
            for (int d = 1; d < 16; d <<= 1) m = fmaxf(m, __shfl_xor(m, d));
            float sum = 0.f;
#pragma unroll
            for (int kt = 0; kt < 16; ++kt) { const float e = __expf(S[kt][j] - m); S[kt][j] = e; sum += e; }
#pragma unroll
            for (int d = 1; d < 16; d <<= 1) sum += __shfl_xor(sum, d);
            inv[j] = rcp_f(sum); }
#pragma unroll
        for (int kt = 0; kt < 16; ++kt)
#pragma unroll
            for (int j = 0; j < 4; ++j) sPw[(4 * lq + j) * 264 + kt * 16 + lr] = f2bf(S[kt][j]);
        asm volatile("s_waitcnt lgkmcnt(0)" ::: "memory");
        f32x4 O[4];
#pragma unroll
        for (int dt = 0; dt < 4; ++dt) O[dt] = (f32x4){0.f, 0.f, 0.f, 0.f};
        {
          const bf16_t* vt = sV + ((rs - base) * 64 + cbase) * 72;
#pragma unroll
          for (int dt = 0; dt < 4; ++dt) { bf16x8 v0[4], v1[4]; tr_frags4<72, 64>(v0, vt, dt * 16); tr_frags4<72, 64>(v1, vt + 4 * 64 * 72, dt * 16);
#pragma unroll
              for (int ks = 0; ks < 4; ++ks) { O[dt] = mfma16(*(const bf16x8*)(sPw + lr * 264 + ks * 32 + 8 * lq), v0[ks], O[dt]); O[dt] = mfma16(*(const bf16x8*)(sPw + lr * 264 + (ks + 4) * 32 + 8 * lq), v1[ks], O[dt]); } } }
        asm volatile("s_waitcnt lgkmcnt(0)" ::: "memory");
        { float* sO = (float*)sPw;
#pragma unroll
          for (int dt = 0; dt < 4; ++dt)
#pragma unroll
              for (int j = 0; j < 4; ++j) sO[(4 * lq + j) * 68 + dt * 16 + lr] = O[dt][j] * inv[j];
          asm volatile("s_waitcnt lgkmcnt(0)" ::: "memory");
          u32x4 gu[2];
#pragma unroll
          for (int i = 0; i < 2; ++i) { const int task = lane + 64 * i, q = task >> 3, cgp = task & 7; gu[i] = *(const u32x4*)(proj + ((size_t)b * SEQ + r * 64 + 16 * qt + q) * 2048 + 1536 + h * 64 + cgp * 8); }
#pragma unroll
          for (int i = 0; i < 2; ++i) { const int task = lane + 64 * i, q = task >> 3, cgp = task & 7; float gv[8], v[8]; unpack8(gu[i], gv);
              const f32x4 o0 = *(const f32x4*)(sO + q * 68 + cgp * 8), o1 = *(const f32x4*)(sO + q * 68 + cgp * 8 + 4);
#pragma unroll
              for (int e = 0; e < 8; ++e) v[e] = (e < 4 ? o0[e] : o1[e - 4]) * silu_f(gv[e]);
              *(u32x4*)(Y + ((size_t)b * SEQ + r * 64 + 16 * qt + q) * 2048 + 1536 + h * 64 + cgp * 8) = pack8(v); } }
        __syncthreads();
    }
}

__device__ __forceinline__ void hy_prep(KPR p, int layer, unsigned char* smem) {
    bf16_t* tile = (bf16_t*)smem;
    const bf16_t* proj = (const bf16_t*)(p.ws + WS_PROJ); bf16_t* hyT = (bf16_t*)(p.ws + WS_AUX);
    const float* cw = p.in[I_HYCW] + layer * 3 * 1536; const float* cb = p.in[I_HYCB] + layer * 1536;
    const int tid = ltid();
    for (int it = blockIdx.x; it < 24 * 64; it += gridDim.x) {
        const int ct = it % 24, tt = it / 24, b = tt >> 4, t0 = (tt & 15) * 512, c0 = ct * 64, cgp = tid & 7;
        float wv[4][8];
#pragma unroll
        for (int e = 0; e < 8; ++e) { wv[0][e] = cw[c0 + cgp * 8 + e]; wv[1][e] = cw[1536 + c0 + cgp * 8 + e]; wv[2][e] = cw[3072 + c0 + cgp * 8 + e]; wv[3][e] = cb[c0 + cgp * 8 + e]; }
#pragma unroll 1
        for (int half = 0; half < 2; ++half) {
            u32x4 u0[4], u1[4], u2[4];
#pragma unroll
            for (int i = 0; i < 4; ++i) { const int r = (tid >> 3) + 64 * (half * 4 + i), tpos = t0 + r;
                const bf16_t* pp = proj + (size_t)(b * SEQ + tpos) * 2048 + c0 + cgp * 8;
                u1[i] = *(const u32x4*)pp; u0[i] = (u32x4){0u, 0u, 0u, 0u}; u2[i] = (u32x4){0u, 0u, 0u, 0u};
                if (tpos > 0) u0[i] = *(const u32x4*)(pp - 2048);
                if (tpos < SEQ - 1) u2[i] = *(const u32x4*)(pp + 2048); }
#pragma unroll
            for (int i = 0; i < 4; ++i) { const int r = (tid >> 3) + 64 * (half * 4 + i); float x0[8], x1[8], x2[8], v[8]; unpack8(u0[i], x0); unpack8(u1[i], x1); unpack8(u2[i], x2);
#pragma unroll
                for (int e = 0; e < 8; ++e) v[e] = wv[3][e] + wv[0][e] * x0[e] + wv[1][e] * x1[e] + wv[2][e] * x2[e];
                *(u32x4*)(tile + r * 72 + cgp * 8) = pack8(v); }
        }
        __syncthreads();
        bf16_t* tileT = tile + 512 * 72;
#pragma unroll
        for (int i = 0; i < 8; ++i) { const int task = tid + 512 * i, c = task & 63, tg = task >> 6; const bf16_t* sp = tile + (tg * 8) * 72 + c; u32x4 w;
            w.x = (unsigned)sp[0] | ((unsigned)sp[72] << 16); w.y = (unsigned)sp[144] | ((unsigned)sp[216] << 16); w.z = (unsigned)sp[288] | ((unsigned)sp[360] << 16); w.w = (unsigned)sp[432] | ((unsigned)sp[504] << 16);
            *(u32x4*)(tileT + c * 520 + tg * 8) = w; }
        __syncthreads();
#pragma unroll
        for (int i = 0; i < 8; ++i) { const int task = tid + 512 * i, c = task >> 6, tg = task & 63;
            *(u32x4*)(hyT + ((size_t)(c0 + c) * 4 + b) * SEQ + t0 + tg * 8) = *(const u32x4*)(tileT + c * 520 + tg * 8); }
    }
}
__device__ __forceinline__ void hy_post(KPR p, unsigned char* smem) {
    bf16_t* tile = (bf16_t*)smem;
    bf16_t* tileT = tile + 64 * 520;
    const bf16_t* proj = (const bf16_t*)(p.ws + WS_PROJ); const bf16_t* hyT = (const bf16_t*)(p.ws + WS_AUX); bf16_t* Y = (bf16_t*)(p.ws + WS_Y);
    const int tid = ltid();
    for (int it = blockIdx.x; it < 8 * 64; it += gridDim.x) {
        const int ct = it & 7, tt = it >> 3, b = tt >> 4, t0 = (tt & 15) * 512;
        { u32x4 tv[8];
#pragma unroll
          for (int i = 0; i < 8; ++i) { const int task = tid + 512 * i, c = task >> 6, tg = task & 63; tv[i] = *(const u32x4*)(hyT + ((size_t)(ct * 64 + c) * 4 + b) * SEQ + t0 + tg * 8); }
#pragma unroll
          for (int i = 0; i < 8; ++i) { const int task = tid + 512 * i, c = task >> 6, tg = task & 63; *(u32x4*)(tile + c * 520 + tg * 8) = tv[i]; } }
        __syncthreads();
#pragma unroll
        for (int i = 0; i < 8; ++i) { const int task = tid + 512 * i, t = task & 511, cgp = task >> 9; const bf16_t* sp = tile + (cgp * 8) * 520 + t; u32x4 w;
            w.x = (unsigned)sp[0] | ((unsigned)sp[520] << 16); w.y = (unsigned)sp[1040] | ((unsigned)sp[1560] << 16); w.z = (unsigned)sp[2080] | ((unsigned)sp[2600] << 16); w.w = (unsigned)sp[3120] | ((unsigned)sp[3640] << 16);
            *(u32x4*)(tileT + t * 72 + cgp * 8) = w; }
        __syncthreads();
        { u32x4 gu[8];
#pragma unroll
          for (int i = 0; i < 8; ++i) { const int task = tid + 512 * i, r = task >> 3, cgp = task & 7; gu[i] = *(const u32x4*)(proj + ((size_t)b * SEQ + t0 + r) * 2048 + 1536 + ct * 64 + cgp * 8); }
#pragma unroll
          for (int i = 0; i < 8; ++i) { const int task = tid + 512 * i, r = task >> 3, cgp = task & 7; float gv[8], v[8]; unpack8(gu[i], gv); unpack8(*(const u32x4*)(tileT + r * 72 + cgp * 8), v);
#pragma unroll
              for (int e = 0; e < 8; ++e) v[e] *= silu_f(gv[e]);
              *(u32x4*)(Y + ((size_t)b * SEQ + t0 + r) * 2048 + ct * 64 + cgp * 8) = pack8(v); } }
    }
}
typedef float f32x2v __attribute__((ext_vector_type(2)));
__device__ __forceinline__ f32x2v cmul(f32x2v a, f32x2v b) {
    f32x2v t, r;
    asm("v_pk_mul_f32 %0, %1, %2 op_sel:[0,0] op_sel_hi:[0,1]" : "=&v"(t) : "v"(a), "v"(b));
    asm("v_pk_fma_f32 %0, %1, %2, %3 op_sel:[1,1,0] op_sel_hi:[1,0,1] neg_lo:[0,1,0]" : "=&v"(r) : "v"(a), "v"(b), "v"(t));
    return r;
}
__device__ __forceinline__ f32x2v cmulc(f32x2v a, f32x2v b) {
    f32x2v t, r;
    asm("v_pk_mul_f32 %0, %1, %2 op_sel:[0,0] op_sel_hi:[0,1] neg_hi:[0,1]" : "=&v"(t) : "v"(a), "v"(b));
    asm("v_pk_fma_f32 %0, %1, %2, %3 op_sel:[1,1,0] op_sel_hi:[1,0,1]" : "=&v"(r) : "v"(a), "v"(b), "v"(t));
    return r;
}
__device__ __forceinline__ constexpr float c16(int m) { return m == 0 ? 1.f : m == 1 ? 0.92387953251f : m == 2 ? 0.70710678119f : m == 3 ? 0.38268343237f : m == 4 ? 0.f : m == 5 ? -0.38268343237f : m == 6 ? -0.70710678119f : -0.92387953251f; }
__device__ __forceinline__ constexpr float s16(int m) { return m == 0 ? 0.f : m == 1 ? 0.38268343237f : m == 2 ? 0.70710678119f : m == 3 ? 0.92387953251f : m == 4 ? 1.f : m == 5 ? 0.92387953251f : m == 6 ? 0.70710678119f : 0.38268343237f; }
#define PIDX(i) ((i) + (((i) >> 6) << 2))
__device__ __forceinline__ constexpr int brev4(int i) { return ((i & 1) << 3) | ((i & 2) << 1) | ((i & 4) >> 1) | ((i & 8) >> 3); }
template <bool INV> __device__ __forceinline__ void r16_core(f32x2v (&x)[16], const f32x2v wa) {
    f32x2v w[16]; w[1] = wa; w[2] = cmul(wa, wa); w[3] = cmul(w[2], wa); w[4] = cmul(w[2], w[2]); w[5] = cmul(w[4], wa); w[6] = cmul(w[3], w[3]); w[7] = cmul(w[4], w[3]); w[8] = cmul(w[4], w[4]);
    w[9] = cmul(w[8], wa); w[10] = cmul(w[5], w[5]); w[11] = cmul(w[8], w[3]); w[12] = cmul(w[6], w[6]); w[13] = cmul(w[8], w[5]); w[14] = cmul(w[7], w[7]); w[15] = cmul(w[8], w[7]);
    if (!INV) {
#pragma unroll
        for (int h = 8; h >= 1; h >>= 1)
#pragma unroll
            for (int i = 0; i < 16; ++i) if ((i & h) == 0) { const int m = (i & (h - 1)) * (8 / h); const f32x2v a = x[i], b = x[i + h]; x[i] = a + b; const f32x2v d = a - b;
                x[i + h] = (m == 0) ? d : (m == 4) ? (f32x2v){d.y, -d.x} : cmul(d, (f32x2v){c16(m), -s16(m)}); }
#pragma unroll
        for (int i = 1; i < 16; ++i) x[i] = cmul(x[i], w[brev4(i)]);
    } else {
#pragma unroll
        for (int i = 1; i < 16; ++i) x[i] = cmulc(x[i], w[brev4(i)]);
#pragma unroll
        for (int h = 1; h <= 8; h <<= 1)
#pragma unroll
            for (int i = 0; i < 16; ++i) if ((i & h) == 0) { const int m = (i & (h - 1)) * (8 / h); const f32x2v b = x[i + h];
                const f32x2v t = (m == 0) ? b : (m == 4) ? (f32x2v){-b.y, b.x} : cmulc(b, (f32x2v){c16(m), -s16(m)}); const f32x2v a = x[i]; x[i] = a + t; x[i + h] = a - t; }
    }
}
template <int S, bool INV> __device__ __forceinline__ void r16_pass(f32x2v* buf) {
    const int tid = ltid();
#pragma unroll
    for (int r = 0; r < 2; ++r) { const int q = tid + 512 * r; int base; float f;
        if (S == 1024) { base = q; f = (float)q * (1.0f / 16384.0f); }
        else if (S == 64) { const int jj = q & 63; base = (q >> 6) * 1024 + jj; f = (float)jj * (1.0f / 1024.0f); }
        else { const int jj = q & 3; base = (q >> 2) * 64 + jj; f = (float)jj * (1.0f / 64.0f); }
        constexpr int PS = (S == 1024) ? 1088 : (S == 64) ? 68 : 4;
        f32x2v* bp = buf + PIDX(base); f32x2v x[16];
#pragma unroll
        for (int m = 0; m < 16; ++m) x[m] = bp[PS * m];
        f32x2v wa = {__builtin_amdgcn_cosf(f), -__builtin_amdgcn_sinf(f)};
        asm volatile("s_nop 1" : "+v"(wa));
        r16_core<INV>(x, wa);
#pragma unroll
        for (int m = 0; m < 16; ++m) bp[PS * m] = x[m]; }
    __syncthreads();
}
template <int MODE> __device__ __forceinline__ void r4_mid(f32x2v* buf, const f32x2v* G) {
    const int tid = ltid();
#pragma unroll 1
    for (int rb = 0; rb < 2; ++rb) {
        f32x4 g01[4], g23[4];
        if (MODE == 1) {
#pragma unroll
            for (int i = 0; i < 4; ++i) { const int q = tid + 512 * (rb * 4 + i); g01[i] = *(const f32x4*)(G + 4 * q); g23[i] = *(const f32x4*)(G + 4 * q + 2); } }
#pragma unroll
        for (int i = 0; i < 4; ++i) { const int q = tid + 512 * (rb * 4 + i); f32x2v* bp = buf + PIDX(4 * q);
            const f32x4 v01 = *(const f32x4*)bp, v23 = *(const f32x4*)(bp + 2);
            const f32x2v x0 = {v01[0], v01[1]}, x1 = {v01[2], v01[3]}, x2 = {v23[0], v23[1]}, x3 = {v23[2], v23[3]};
            const f32x2v a0 = x0 + x2, a2 = x0 - x2, a1 = x1 + x3, d = x1 - x3; const f32x2v a3 = {d.y, -d.x};
            f32x2v b0 = a0 + a1, b1 = a0 - a1, b2 = a2 + a3, b3 = a2 - a3;
            if (MODE == 1) {
                b0 = cmul(b0, (f32x2v){g01[i][0], g01[i][1]}); b1 = cmul(b1, (f32x2v){g01[i][2], g01[i][3]}); b2 = cmul(b2, (f32x2v){g23[i][0], g23[i][1]}); b3 = cmul(b3, (f32x2v){g23[i][2], g23[i][3]});
                const f32x2v c0 = b0 + b1, c1 = b0 - b1, c2 = b2 + b3, c3 = b2 - b3; const f32x2v t = {-c3.y, c3.x};
                b0 = c0 + c2; b2 = c0 - c2; b1 = c1 + t; b3 = c1 - t;
            }
            *(f32x4*)bp = (f32x4){b0.x, b0.y, b1.x, b1.y}; *(f32x4*)(bp + 2) = (f32x4){b2.x, b2.y, b3.x, b3.y}; }
    }
    __syncthreads();
}
__device__ __forceinline__ int brev14(int x) { return (int)(__brev((unsigned)x) >> 18); }
__device__ __forceinline__ void hy_fft(KPR p, int layer, unsigned char* smem) {
    f32x2v* buf = (f32x2v*)smem;
    f32x4* sW3 = (f32x4*)(smem + 139264); float* sDec = (float*)(smem + 139264 + 1024);
    f32x2v* Gs = (f32x2v*)(p.ws + WS_XN) + (size_t)blockIdx.x * 32768;
    f32x2v* Zs = (f32x2v*)(p.ws + WS_PROJ + (size_t)32768 * 2048 * 2) + (size_t)blockIdx.x * 8192;
    bf16_t* hyT = (bf16_t*)(p.ws + WS_AUX); const float* hid = (const float*)(p.ws + WS_HID) + (size_t)layer * 8192 * 64;
    const int tid = ltid();
    for (int c = blockIdx.x; c < 512; c += gridDim.x) {
        if (tid < 256) ((float*)sW3)[tid] = p.in[I_HYW3][(size_t)layer * 64 * 2048 + (tid >> 2) * 2048 + (tid & 3) * 512 + c];
        if (tid < 4) sDec[tid] = p.in[I_HYDECAY][layer * 2048 + tid * 512 + c];
        __syncthreads();
#ifndef REP_FILT
#define REP_FILT 1
#endif
#ifndef REP_CONV1
#define REP_CONV1 1
#endif
        for (int frep = 0; frep < REP_FILT; ++frep) {
#pragma unroll 1
        for (int i = 0; i < 4; ++i) { const int t = 4 * (tid + 512 * i); const float* hp = hid + t; f32x4 a0 = {0.f, 0.f, 0.f, 0.f}, a1 = a0, a2 = a0, a3 = a0;
#pragma unroll 1
            for (int kb = 0; kb < 64; kb += 32) { f32x4 hv[32];
#pragma unroll
                for (int k = 0; k < 32; ++k) hv[k] = *(const f32x4*)(hp + (size_t)(kb + k) * 8192);
#pragma unroll
                for (int k = 0; k < 32; ++k) { const f32x4 w = sW3[kb + k]; a0 += hv[k] * w[0]; a1 += hv[k] * w[1]; a2 += hv[k] * w[2]; a3 += hv[k] * w[3]; } }
#pragma unroll
            for (int e = 0; e < 4; ++e) { const int te = t + e; const float tn = (float)te * (1.0f / 8192.0f);
                buf[PIDX(te)] = (f32x2v){a0[e] * __expf(-tn * sDec[0]), a2[e] * __expf(-tn * sDec[2])};
                if (te >= 1) buf[PIDX(16384 - te)] = (f32x2v){a1[e] * __expf(-tn * sDec[1]), a3[e] * __expf(-tn * sDec[3])}; else buf[PIDX(8192)] = (f32x2v){0.f, 0.f}; } }
        __syncthreads();
        r16_pass<1024, false>(buf); r16_pass<64, false>(buf); r16_pass<4, false>(buf); r4_mid<0>(buf, nullptr);
        const float skip0 = p.in[I_HYSKIP][layer * 1024 + c], skip1 = p.in[I_HYSKIP][layer * 1024 + 512 + c];
#pragma unroll 4
        for (int r = 0; r < 32; ++r) { const int pz = tid + 512 * r, k = brev14(pz), pm = brev14((16384 - k) & 16383);
            const f32x2v Z = buf[PIDX(pz)], Zm = buf[PIDX(pm)]; const float hs = 0.5f / 16384.0f;
            Gs[pz] = (f32x2v){(Z.x + Zm.x) * hs + skip0 * (1.0f / 16384.0f), (Z.y - Zm.y) * hs}; Gs[16384 + pz] = (f32x2v){(Z.y + Zm.y) * hs + skip1 * (1.0f / 16384.0f), (Zm.x - Z.x) * hs}; }
        __syncthreads(); }
#pragma unroll 1
        for (int pr = 0; pr < 2; ++pr) {
            bf16_t* v0 = hyT + ((size_t)c * 4 + 2 * pr) * SEQ; bf16_t* v1 = v0 + SEQ;
            const bf16_t* p0 = hyT + ((size_t)(512 + c) * 4 + 2 * pr) * SEQ; const bf16_t* p1 = p0 + SEQ;
            const bf16_t* q0 = hyT + ((size_t)(1024 + c) * 4 + 2 * pr) * SEQ; const bf16_t* q1 = q0 + SEQ;
            u32x4 uv0[2], uv1[2], ux0[2], ux1[2], uy0[2], uy1[2];
#pragma unroll
            for (int r = 0; r < 2; ++r) { const int t0 = 8 * (tid + 512 * r); uv0[r] = *(const u32x4*)(v0 + t0); uv1[r] = *(const u32x4*)(v1 + t0);
                ux0[r] = *(const u32x4*)(p0 + t0); ux1[r] = *(const u32x4*)(p1 + t0); uy0[r] = *(const u32x4*)(q0 + t0); uy1[r] = *(const u32x4*)(q1 + t0); }
            for (int crep = 0; crep < REP_CONV1; ++crep) {
#pragma unroll
            for (int r = 0; r < 2; ++r) { const int t0 = 8 * (tid + 512 * r); float a[8], b[8]; unpack8(uv0[r], a); unpack8(uv1[r], b);
                f32x4* bp = (f32x4*)(buf + PIDX(t0)); f32x4* bz = (f32x4*)(buf + PIDX(8192 + t0));
#pragma unroll
                for (int e = 0; e < 4; ++e) { bp[e] = (f32x4){a[2 * e], b[2 * e], a[2 * e + 1], b[2 * e + 1]}; bz[e] = (f32x4){0.f, 0.f, 0.f, 0.f}; } }
            __syncthreads();
            r16_pass<1024, false>(buf); r16_pass<64, false>(buf); r16_pass<4, false>(buf); r4_mid<1>(buf, Gs);
            r16_pass<4, true>(buf); r16_pass<64, true>(buf); r16_pass<1024, true>(buf);
#pragma unroll
            for (int r = 0; r < 2; ++r) { const int t0 = 8 * (tid + 512 * r); float a[8], b[8], xa[8], xb[8];
                unpack8(uv0[r], a); unpack8(uv1[r], b); unpack8(ux0[r], xa); unpack8(ux1[r], xb);
                f32x4* bp = (f32x4*)(buf + PIDX(t0)); f32x4* bz = (f32x4*)(buf + PIDX(8192 + t0));
#pragma unroll
                for (int e = 0; e < 4; ++e) { const f32x4 cv = bp[e];
                    const f32x4 z = {xa[2 * e] * cv[0], xb[2 * e] * cv[1], xa[2 * e + 1] * cv[2], xb[2 * e + 1] * cv[3]};
                    bp[e] = z; bz[e] = (f32x4){0.f, 0.f, 0.f, 0.f}; } }
            __syncthreads(); }
            r16_pass<1024, false>(buf); r16_pass<64, false>(buf); r16_pass<4, false>(buf); r4_mid<1>(buf, Gs + 16384);
            r16_pass<4, true>(buf); r16_pass<64, true>(buf); r16_pass<1024, true>(buf);
#pragma unroll
            for (int r = 0; r < 2; ++r) { const int t0 = 8 * (tid + 512 * r); float xa[8], xb[8], ya[8], yb[8];
                unpack8(uy0[r], xa); unpack8(uy1[r], xb);
                const f32x4* bp = (const f32x4*)(buf + PIDX(t0));
#pragma unroll
                for (int e = 0; e < 4; ++e) { const f32x4 cv = bp[e];
                    ya[2 * e] = xa[2 * e] * cv[0]; yb[2 * e] = xb[2 * e] * cv[1]; ya[2 * e + 1] = xa[2 * e + 1] * cv[2]; yb[2 * e + 1] = xb[2 * e + 1] * cv[3]; }
                *(u32x4*)(v0 + t0) = pack8(ya); *(u32x4*)(v1 + t0) = pack8(yb); }
            __syncthreads();
        }
    }
}
__global__ void __launch_bounds__(512) hybrid_fwd(Params p_unused) {
#define p (*kp())
    extern __shared__ __attribute__((aligned(16))) unsigned char smem[];
    cg::grid_group grid = cg::this_grid();
    volatile LAS unsigned* bst = (volatile LAS unsigned*)(smem + LDS_BYTES - 16);
    if (threadIdx.x < 4) bst[threadIdx.x] = 0u;
    __syncthreads();
    (void)xcd_barrier_post((unsigned*)(p.ws + WS_BAR), bst);
#define GSYNC() do { unsigned _z = 0u; asm volatile("" : "+v"(_z)); unsigned* _bar = (unsigned*)(p.ws + WS_BAR) + _z; XcdBarrier _b; _b.bar = _bar; _b.x = xb_xcc_id(); _b.st = bst; xcd_barrier(_b); } while (0)
    bf16_t* WBT = (bf16_t*)(p.ws + WS_WBT); bf16_t* WOT = (bf16_t*)(p.ws + WS_WOT); bf16_t* XN = (bf16_t*)(p.ws + WS_XN); float* SPEC = (float*)(p.ws + WS_SPEC);
    bf16_t* Yb = (bf16_t*)(p.ws + WS_Y); bf16_t* PROJ = (bf16_t*)(p.ws + WS_PROJ);
    for (int l = 0; l < 2; ++l) {
        conv_wt(p.in[I_WIN] + (size_t)l * 1024 * 8224, 1024, 8224, WBT + (size_t)l * 8224 * 1024, 8224, 1, smem);
        conv_wt(p.in[I_WOUT] + (size_t)l * 2048 * 1024, 2048, 1024, WOT + (size_t)l * 1024 * 2048, 1024, 0, smem);
    }
    hid_phase(p, smem);
    if (p.ws == nullptr) grid.sync();
    GSYNC();
#ifndef REP_M1A
#define REP_M1A 1
#endif
#ifndef REP_M3A
#define REP_M3A 1
#endif
#ifndef REP_M1B
#define REP_M1B 1
#endif
#ifndef REP_M3B
#define REP_M3B 1
#endif
#ifndef REP_POST
#define REP_POST 1
#endif
#ifndef REP_NORM
#define REP_NORM 1
#endif
#ifndef REP_GEMM
#define REP_GEMM 1
#endif
#ifndef REP_MB
#define REP_MB 1
#endif
#ifndef REP_ML
#define REP_ML 1
#endif
#ifndef REP_NA
#define REP_NA 1
#endif
#ifndef REP_HY
#define REP_HY 1
#endif
#ifndef REP_SYNC
#define REP_SYNC 0
#endif
    for (int l = 0; l < 2; ++l) {
        const float* xin = (l == 0) ? p.in[I_X] : p.out;
        const bf16_t* Wl = WBT + (size_t)l * 8224 * 1024;
        for (int r6 = 0; r6 < REP_NORM; ++r6) { norm_phase(xin, p.in[I_NORMW] + l * 1024, Wl + (size_t)8192 * 1024, XN, SPEC, smem);
        GSYNC(); }
        for (int rep = 0; rep < REP_GEMM; ++rep) { run_gemm(smem, XN, Wl + (size_t)2048 * 1024, NTOK, 1536, 1024, EpiProj{PROJ, 1536});
        GSYNC(); }
        for (int rep = 0; rep < REP_MB; ++rep) {
        for (int r1 = 0; r1 < REP_M1A; ++r1) { ssd_m1<0>(p, l, smem); GSYNC(); }
        ssd_m2<0>(p); GSYNC();
        for (int r3 = 0; r3 < REP_M3A; ++r3) { ssd_m3_mamba(p, l, smem); GSYNC(); } }
        for (int rep = 0; rep < REP_SYNC; ++rep) GSYNC();
        for (int rep = 0; rep < REP_GEMM; ++rep) { run_gemm(smem, XN, Wl + (size_t)3584 * 1024, NTOK, 2560, 1024, EpiProj{PROJ, 2560});
        GSYNC(); }
        for (int rep = 0; rep < REP_ML; ++rep) {
        for (int r1 = 0; r1 < REP_M1B; ++r1) { ssd_m1<1>(p, l, smem); GSYNC(); }
        ssd_m2<1>(p); GSYNC();
        for (int r3 = 0; r3 < REP_M3B; ++r3) { ssd_m3<1>(p, l, smem); GSYNC(); } }
        for (int rep = 0; rep < REP_GEMM; ++rep) { run_gemm(smem, XN, Wl + (size_t)6144 * 1024, NTOK, 2048, 1024, EpiProj{PROJ, 2048});
        GSYNC(); }
        for (int rep = 0; rep < REP_NA; ++rep) { na_phase(p, l, smem); GSYNC(); }
        for (int rep = 0; rep < REP_GEMM; ++rep) { run_gemm(smem, XN, Wl, NTOK, 2048, 1024, EpiProj{PROJ, 2048});
        GSYNC(); }
#ifndef REP_HYPREP
#define REP_HYPREP 1
#endif
        for (int rep = 0; rep < REP_HY; ++rep) {
        for (int rep2 = 0; rep2 < REP_HYPREP; ++rep2) { hy_prep(p, l, smem); GSYNC(); }
        hy_fft(p, l, smem); GSYNC(); }
        for (int r5 = 0; r5 < REP_POST; ++r5) { hy_post(p, smem); GSYNC(); }
        run_gemm(smem, Yb, WOT + (size_t)l * 1024 * 2048, NTOK, 1024, 2048, EpiResid{p.out, xin, 1024});
        if (l == 0) GSYNC();
    }
}

#undef p
extern "C" void kernel_launch(void* const* d_in, const int* in_sizes, int n_in, void* d_out, int out_size, void* d_ws, size_t ws_size, hipStream_t stream) {
    static int grid = 0;
    if (grid == 0) {
        if (n_in != 27 || ws_size < WS_END) { fprintf(stderr, "kernel_launch: need 27 inputs and %zu bytes of workspace (got %d, %zu)\n", (size_t)WS_END, n_in, ws_size); grid = -1; return; }
        int dev = 0, cus = 0, per_cu = 0;
        hipGetDevice(&dev); hipDeviceGetAttribute(&cus, hipDeviceAttributeMultiprocessorCount, dev);
        if (hipFuncSetAttribute((const void*)hybrid_fwd, hipFuncAttributeMaxDynamicSharedMemorySize, LDS_BYTES) != hipSuccess) { fprintf(stderr, "kernel_launch: hipFuncSetAttribute failed\n"); grid = -1; return; }
        if (hipOccupancyMaxActiveBlocksPerMultiprocessor(&per_cu, (const void*)hybrid_fwd, 512, LDS_BYTES) != hipSuccess || per_cu < 1) { fprintf(stderr, "kernel_launch: occupancy query failed (%d)\n", per_cu); grid = -1; return; }
        grid = cus * per_cu; if (grid > 256) grid = 256;
    }
    if (grid < 0) return;
    if (hipMemsetAsync((char*)d_ws + WS_BAR, 0, 16384, stream) != hipSuccess) { fprintf(stderr, "kernel_launch: memset of barrier words failed\n"); return; }
    Params p{};
    for (int i = 0; i < 27; ++i) p.in[i] = (const float*)d_in[i];
    p.out = (float*)d_out; p.ws = (unsigned char*)d_ws;
    void* args[] = {&p};
    hipError_t e = hipLaunchCooperativeKernel((const void*)hybrid_fwd, dim3(grid), dim3(512), args, LDS_BYTES, stream);
    if (e != hipSuccess) fprintf(stderr, "cooperative launch failed: %s (grid %d)\n", hipGetErrorString(e), grid);
}
```
